# Optimizing an MI355X kernel written in HIP

```python
import jax, jax.numpy as jnp
from jax import lax
import numpy as np

D_MODEL = 2048
BATCH = 1
SEQ = 8192
DEPTH = 1
DEC_BATCH = 8
DEC_SEQ = 16
PAST_LEN = 2048

CHUNK = 64
D_RNN = 2048
N_LRU_HEADS = 16
LRU_HEAD_DIM = D_RNN // N_LRU_HEADS
CONV_A_W = 4
RG_C = 8.0
D_CONV = 1024
CONV_B_W = 3
D_FF = 5632
CONV_F_W = 3
N_MEM = 256
N_XHEADS = 4
XHEAD_DIM = D_MODEL // N_XHEADS
EPS = 1e-6

kernel_name = 'hawk_shortconv_convffn_memxattn_step'


def rmsnorm(x, g):
    xf = x.astype(jnp.float32)
    y = xf * lax.rsqrt(jnp.mean(xf * xf, axis=-1, keepdims=True) + EPS)
    return (y * g.astype(jnp.float32)).astype(x.dtype)


def causal_dwconv(x, state, w, b=None):
    width = w.shape[0]
    t = x.shape[1]
    xp = jnp.concatenate([state.astype(x.dtype), x], axis=1)
    y = xp[:, 0:t] * w[0]
    for k in range(1, width):
        y = y + xp[:, k:k + t] * w[k]
    if b is not None:
        y = y + b
    return y, xp[:, t:]


def blockdiag(x, w, b):
    bsz, t, _ = x.shape
    xh = x.reshape(bsz, t, N_LRU_HEADS, LRU_HEAD_DIM)
    return (jnp.einsum('bthi,hij->bthj', xh, w) + b).reshape(bsz, t, D_RNN)


def rglru_scan(a, b, h0):
    b = b.at[:, 0].add(a[:, 0] * h0)
    def comb(l, r):
        return (l[0] * r[0], r[0] * l[1] + r[1])
    _, h = lax.associative_scan(comb, (a, b), axis=1)
    return h


def memory_kv(mem, g_mem, w_k, w_v):
    bsz = mem.shape[0]
    mn = rmsnorm(mem, g_mem)
    k = (mn @ w_k).reshape(bsz, N_MEM, N_XHEADS, XHEAD_DIM)
    v = (mn @ w_v).reshape(bsz, N_MEM, N_XHEADS, XHEAD_DIM)
    return k, v


def layer(x, pos0, mem_k, mem_v, s_a, h0, s_b, s_f, p):
    bsz, t, _ = x.shape
    u = rmsnorm(x, p['g_mix_pre'])
    z = u @ p['w_in']
    cuts = [D_RNN, 2 * D_RNN, 2 * D_RNN + D_CONV, 2 * D_RNN + 2 * D_CONV,
            2 * D_RNN + 3 * D_CONV, 2 * D_RNN + 3 * D_CONV + D_MODEL]
    xa, ga, gb_out, gc_in, hb, gate_a, gate_b = jnp.split(z, cuts, axis=-1)
    xa, new_s_a = causal_dwconv(xa, s_a, p['conv_a_w'], p['conv_a_b'])
    r = jax.nn.sigmoid(blockdiag(xa, p['w_r'], p['b_r']).astype(jnp.float32))
    i = jax.nn.sigmoid(blockdiag(xa, p['w_i'], p['b_i']).astype(jnp.float32))
    log_a = -RG_C * r * jax.nn.softplus(-p['lru_lambda'].astype(jnp.float32))
    a = jnp.exp(log_a)
    pos = pos0 + jnp.arange(t)
    reset = (pos == 0)[None, :, None]
    mult = jnp.where(reset, 1.0, jnp.sqrt(-jnp.expm1(2.0 * log_a)))
    h = rglru_scan(a, mult * i * xa.astype(jnp.float32), h0.astype(jnp.float32))
    new_h = h[:, -1]
    y_a = (h.astype(x.dtype) * jax.nn.gelu(ga, approximate=True)) @ p['p_a']
    c_in = gc_in * hb
    c_out, new_s_b = causal_dwconv(c_in, s_b, p['conv_b_w'])
    y_b = (gb_out * c_out) @ p['p_b']
    mix = jax.nn.sigmoid(gate_a) * y_a + jax.nn.sigmoid(gate_b) * y_b
    x = x + rmsnorm(mix @ p['w_o'], p['g_mix_post'])
    u = rmsnorm(x, p['g_x_pre'])
    q = (u @ p['w_q']).reshape(bsz, t, N_XHEADS, XHEAD_DIM)
    s = jnp.einsum('bthd,bmhd->bhtm', q, mem_k.astype(q.dtype)).astype(jnp.float32) * (XHEAD_DIM ** -0.5)
    att = jax.nn.softmax(s, axis=-1).astype(x.dtype)
    o = jnp.einsum('bhtm,bmhd->bthd', att, mem_v.astype(x.dtype)).reshape(bsz, t, D_MODEL)
    x = x + rmsnorm(o @ p['w_xo'], p['g_x_post'])
    u = rmsnorm(x, p['g_ffn_pre'])
    up = u @ p['w_up']
    up, new_s_f = causal_dwconv(up, s_f, p['ffn_conv_w'], p['ffn_conv_b'])
    g, v = jnp.split(up, 2, axis=-1)
    y = (jax.nn.gelu(g, approximate=True) * v) @ p['w_down']
    x = x + rmsnorm(y, p['g_ffn_post'])
    return x, new_s_a, new_h, new_s_b, new_s_f


def setup_inputs(seed: int = 0) -> dict:
    key = jax.random.key(seed)
    ks = jax.random.split(key, 40)
    f32 = jnp.float32
    def nrm(k, shape, scale):
        return jax.random.normal(k, shape, f32) * scale
    def gain(k, n):
        return 1.0 + 0.02 * jax.random.normal(k, (DEPTH, n), f32)
    n_in = 2 * D_RNN + 3 * D_CONV + 2 * D_MODEL
    u = jax.random.uniform(ks[12], (DEPTH, D_RNN), f32, minval=0.9, maxval=0.999)
    sa = u ** (1.0 / RG_C)
    lam = jnp.log(sa) - jnp.log1p(-sa)
    return {
        'x_prompt': nrm(ks[0], (BATCH, SEQ, D_MODEL), 1.0),
        'x_sample': nrm(ks[1], (DEC_BATCH, DEC_SEQ, D_MODEL), 1.0),
        'mem_prompt': nrm(ks[2], (BATCH, N_MEM, D_MODEL), 1.0),
        'state_conv_a': nrm(ks[3], (DEPTH, DEC_BATCH, CONV_A_W - 1, D_RNN), 1.0),
        'state_rglru': nrm(ks[4], (DEPTH, DEC_BATCH, D_RNN), 0.5),
        'state_conv_b': nrm(ks[5], (DEPTH, DEC_BATCH, CONV_B_W - 1, D_CONV), 1.0),
        'state_ffn_conv': nrm(ks[6], (DEPTH, DEC_BATCH, CONV_F_W - 1, 2 * D_FF), 1.0),
        'cache_mem_k': nrm(ks[7], (DEPTH, DEC_BATCH, N_MEM, N_XHEADS, XHEAD_DIM), 1.0),
        'cache_mem_v': nrm(ks[8], (DEPTH, DEC_BATCH, N_MEM, N_XHEADS, XHEAD_DIM), 1.0),
        'g_mix_pre': gain(ks[9], D_MODEL),
        'g_mix_post': gain(ks[10], D_MODEL),
        'w_in': nrm(ks[11], (DEPTH, D_MODEL, n_in), D_MODEL ** -0.5),
        'conv_a_w': nrm(ks[13], (DEPTH, CONV_A_W, D_RNN), CONV_A_W ** -0.5),
        'conv_a_b': nrm(ks[14], (DEPTH, D_RNN), 0.01),
        'w_r': nrm(ks[15], (DEPTH, N_LRU_HEADS, LRU_HEAD_DIM, LRU_HEAD_DIM), LRU_HEAD_DIM ** -0.5),
        'b_r': nrm(ks[16], (DEPTH, N_LRU_HEADS, LRU_HEAD_DIM), 0.01),
        'w_i': nrm(ks[17], (DEPTH, N_LRU_HEADS, LRU_HEAD_DIM, LRU_HEAD_DIM), LRU_HEAD_DIM ** -0.5),
        'b_i': nrm(ks[18], (DEPTH, N_LRU_HEADS, LRU_HEAD_DIM), 0.01),
        'lru_lambda': lam,
        'conv_b_w': nrm(ks[19], (DEPTH, CONV_B_W, D_CONV), CONV_B_W ** -0.5),
        'p_a': nrm(ks[20], (DEPTH, D_RNN, D_MODEL), D_RNN ** -0.5),
        'p_b': nrm(ks[21], (DEPTH, D_CONV, D_MODEL), D_CONV ** -0.5),
        'w_o': nrm(ks[22], (DEPTH, D_MODEL, D_MODEL), D_MODEL ** -0.5),
        'g_x_pre': gain(ks[23], D_MODEL),
        'g_x_post': gain(ks[24], D_MODEL),
        'g_mem': gain(ks[25], D_MODEL),
        'w_q': nrm(ks[26], (DEPTH, D_MODEL, D_MODEL), D_MODEL ** -0.5),
        'w_k': nrm(ks[27], (DEPTH, D_MODEL, D_MODEL), D_MODEL ** -0.5),
        'w_v': nrm(ks[28], (DEPTH, D_MODEL, D_MODEL), D_MODEL ** -0.5),
        'w_xo': nrm(ks[29], (DEPTH, D_MODEL, D_MODEL), D_MODEL ** -0.5),
        'g_ffn_pre': gain(ks[30], D_MODEL),
        'g_ffn_post': gain(ks[31], D_MODEL),
        'w_up': nrm(ks[32], (DEPTH, D_MODEL, 2 * D_FF), D_MODEL ** -0.5),
        'ffn_conv_w': nrm(ks[33], (DEPTH, CONV_F_W, 2 * D_FF), CONV_F_W ** -0.5),
        'ffn_conv_b': nrm(ks[34], (DEPTH, 2 * D_FF), 0.01),
        'w_down': nrm(ks[35], (DEPTH, D_FF, D_MODEL), D_FF ** -0.5),
    }


def reference(x_prompt, x_sample, mem_prompt, state_conv_a, state_rglru, state_conv_b, state_ffn_conv,
              cache_mem_k, cache_mem_v, g_mix_pre, g_mix_post, w_in, conv_a_w, conv_a_b, w_r, b_r, w_i, b_i,
              lru_lambda, conv_b_w, p_a, p_b, w_o, g_x_pre, g_x_post, g_mem, w_q, w_k, w_v, w_xo,
              g_ffn_pre, g_ffn_post, w_up, ffn_conv_w, ffn_conv_b, w_down):
    yp, ys = x_prompt, x_sample
    pca, prh, pcb, pcf, pmk, pmv = [], [], [], [], [], []
    sca, srh, scb, scf = [], [], [], []
    for l in range(DEPTH):
        p = {'g_mix_pre': g_mix_pre[l], 'g_mix_post': g_mix_post[l], 'w_in': w_in[l],
             'conv_a_w': conv_a_w[l], 'conv_a_b': conv_a_b[l], 'w_r': w_r[l], 'b_r': b_r[l],
             'w_i': w_i[l], 'b_i': b_i[l], 'lru_lambda': lru_lambda[l], 'conv_b_w': conv_b_w[l],
             'p_a': p_a[l], 'p_b': p_b[l], 'w_o': w_o[l], 'g_x_pre': g_x_pre[l], 'g_x_post': g_x_post[l],
             'w_q': w_q[l], 'w_xo': w_xo[l], 'g_ffn_pre': g_ffn_pre[l], 'g_ffn_post': g_ffn_post[l],
             'w_up': w_up[l], 'ffn_conv_w': ffn_conv_w[l], 'ffn_conv_b': ffn_conv_b[l], 'w_down': w_down[l]}
        mk, mv = memory_kv(mem_prompt, g_mem[l], w_k[l], w_v[l])
        dt = yp.dtype
        z_a = jnp.zeros((BATCH, CONV_A_W - 1, D_RNN), dt)
        z_h = jnp.zeros((BATCH, D_RNN), jnp.float32)
        z_b = jnp.zeros((BATCH, CONV_B_W - 1, D_CONV), dt)
        z_f = jnp.zeros((BATCH, CONV_F_W - 1, 2 * D_FF), dt)
        yp, na, nh, nb, nf = layer(yp, 0, mk, mv, z_a, z_h, z_b, z_f, p)
        pca.append(na); prh.append(nh); pcb.append(nb); pcf.append(nf); pmk.append(mk); pmv.append(mv)
        ys, na, nh, nb, nf = layer(ys, PAST_LEN, cache_mem_k[l], cache_mem_v[l], state_conv_a[l],
                                   state_rglru[l], state_conv_b[l], state_ffn_conv[l], p)
        sca.append(na); srh.append(nh); scb.append(nb); scf.append(nf)
    return (yp, ys, jnp.stack(pca), jnp.stack(prh), jnp.stack(pcb), jnp.stack(pcf), jnp.stack(pmk), jnp.stack(pmv),
            jnp.stack(sca), jnp.stack(srh), jnp.stack(scb), jnp.stack(scf))
```

```cpp
#include <hip/hip_runtime.h>
#include <hip/hip_cooperative_groups.h>
#include <cstdio>
#include <cstdint>
namespace cg = cooperative_groups;

#ifndef N_LAUNCH_MODE
#define N_LAUNCH_MODE 1
#endif
#ifndef PROBE_PH
#define PROBE_PH -1
#endif
#ifndef USE_XCD_BAR
#define USE_XCD_BAR 1
#endif

#define LAS __attribute__((address_space(3)))
typedef unsigned short bf16_t;
typedef short bf16x8 __attribute__((ext_vector_type(8)));
typedef float f32x4 __attribute__((ext_vector_type(4)));
typedef float f32x16 __attribute__((ext_vector_type(16)));
typedef unsigned u32x4 __attribute__((ext_vector_type(4)));
typedef unsigned u32x2 __attribute__((ext_vector_type(2)));

constexpr int D = 2048, SEQ = 8192, MR = 8320, MP = 8448, NIN = 11264, DC = 1024, DFF = 5632, NUP = 11264, NMEM = 256;
constexpr int Z_GA = 2048, Z_GB = 4096, Z_GC = 5120, Z_HB = 6144, Z_GATEA = 7168, Z_GATEB = 9216;
constexpr int NCHUNK = 130;
constexpr float EPS = 1e-6f;
constexpr size_t O_YP = 0, O_PCA = 17039360, O_PRH = 17045504, O_PCB = 17047552, O_PCF = 17049600, O_PMK = 17072128, O_PMV = 17596416,
                 O_SCA = 18120704, O_SRH = 18169856, O_SCB = 18186240, O_SCF = 18202624;
constexpr size_t WS_WKV = 0, WS_WPA = 16777216, WS_WPB = 25165824, WS_WO = 29360128, WS_WQ = 37748736, WS_WXO = 46137344,
                 WS_WR = 54525952, WS_WI = 55050240, WS_KB = 55574528, WS_VT = 56623104, WS_MN = 57671680, WS_PSP = 58720256, WS_PSS = 59785216,
                 WS_BAR = 60850176, WS_Z = 60915712, WS_T = WS_Z + 190316544, WS_B = WS_T + 46137344, WS_END = WS_B + 121110528;
constexpr size_t B1 = WS_B, B2 = WS_B + 34603008, B3 = WS_B + 69206016, B4 = WS_B + 103809024;
constexpr size_t WS_WIN = WS_T, WS_WUP = WS_B, WS_U3 = WS_B + 46137344, WS_G = WS_B, WS_WDN = WS_B + 95158272;
constexpr int LDS_BYTES = 153600;

struct Params { const float* in[36]; float* out; unsigned char* ws; int ph_lo, ph_hi; };

__device__ __forceinline__ unsigned f2bf(float f) { unsigned u = __float_as_uint(f); return (u + 0x7fffu + ((u >> 16) & 1u)) >> 16; }
__device__ __forceinline__ unsigned pk2(float lo, float hi) { return f2bf(lo) | (f2bf(hi) << 16); }
__device__ __forceinline__ unsigned pk2h(float lo, float hi) { unsigned r; asm("v_cvt_pk_bf16_f32 %0, %1, %2" : "=v"(r) : "v"(lo), "v"(hi)); return r; }
__device__ __forceinline__ float bf_lo(unsigned u) { return __uint_as_float(u << 16); }
__device__ __forceinline__ float bf_hi(unsigned u) { return __uint_as_float(u & 0xffff0000u); }
__device__ __forceinline__ float bf1(bf16_t b) { return __uint_as_float(((unsigned)b) << 16); }
__device__ __forceinline__ float wave_sum(float v) {
#pragma unroll
    for (int o = 1; o < 64; o <<= 1) v += __shfl_xor(v, o);
    return v;
}
__device__ __forceinline__ float wave_max(float v) {
#pragma unroll
    for (int o = 1; o < 64; o <<= 1) v = fmaxf(v, __shfl_xor(v, o));
    return v;
}
__device__ __forceinline__ float sigmoidf_(float x) { return __builtin_amdgcn_rcpf(1.0f + __expf(-x)); }
__device__ __forceinline__ float gelu_tanh(float x) { const float u = 1.5957691216057308f * (x + 0.044715f * x * x * x); return x * __builtin_amdgcn_rcpf(1.0f + __expf(-u)); }
#define LDS_WAIT() asm volatile("s_waitcnt lgkmcnt(0)" ::: "memory")
__device__ __forceinline__ int lane_id_() { int l; asm volatile("v_mbcnt_lo_u32_b32 %0, -1, 0\n\tv_mbcnt_hi_u32_b32 %0, -1, %0" : "=v"(l)); return l; }

#define XB_TMO      128
#define XB_XCNT(j)  (256  + 64 * (j))
#define XB_XSUB(j)  (1280 + 64 * (j))
#define XB_XGEN(j)  (2304 + 64 * (j))
#define XB_TOP      3328
#define XB_TOPGEN   3392
#define XCD_BAR_WORDS 3456
#define XB_SPIN_CAP (1u << 22)
__device__ __forceinline__ unsigned xb_ld(unsigned* p)              { return __hip_atomic_load(p, __ATOMIC_RELAXED, __HIP_MEMORY_SCOPE_AGENT); }
__device__ __forceinline__ unsigned xb_add(unsigned* p, unsigned v) { return __hip_atomic_fetch_add(p, v, __ATOMIC_RELAXED, __HIP_MEMORY_SCOPE_AGENT); }
__device__ __forceinline__ unsigned xb_xcc_id() { return (unsigned)__builtin_amdgcn_s_getreg((3 << 11) | 20) & 0xFu; }
#define XB_SPIN(cond, bar) do { unsigned _sp = 0; while (cond) { __builtin_amdgcn_s_sleep(1); \
    if ((++_sp & 255u) == 0u) { if (xb_ld(&(bar)[XB_TMO])) break; if (_sp > XB_SPIN_CAP) { atomicAdd(&(bar)[XB_TMO], 1u); break; } } } } while (0)
struct XcdBarrier { unsigned* bar; unsigned x; volatile LAS unsigned* st; };
__device__ __forceinline__ XcdBarrier xcd_barrier_post(unsigned* bar, volatile LAS unsigned* st) {
    XcdBarrier b; b.bar = bar; b.x = xb_xcc_id(); b.st = st;
    if (threadIdx.x == 0) (void)xb_add(&bar[XB_XCNT(b.x)], 1u);
    return b;
}
__device__ __forceinline__ void xcd_barrier_complete(unsigned* bar, unsigned x, unsigned& nloc, unsigned& nx) {
    const unsigned G = gridDim.x * gridDim.y * gridDim.z;
    unsigned sum, cnt, mine, sp = 0u;
    for (;;) {
        sum = 0u; cnt = 0u; mine = 0u;
#pragma unroll
        for (unsigned j = 0; j < 16; ++j) { const unsigned c = xb_ld(&bar[XB_XCNT(j)]); sum += c; cnt += (c > 0u) ? 1u : 0u; mine = (j == x) ? c : mine; }
        if (sum == G) break;
        __builtin_amdgcn_s_sleep(1);
        if ((++sp & 255u) == 0u) { if (xb_ld(&bar[XB_TMO])) break; if (sp > XB_SPIN_CAP) { atomicAdd(&bar[XB_TMO], 1u); break; } }
    }
    nloc = mine > 0u ? mine : 1u; nx = cnt > 0u ? cnt : 1u;
}
__device__ __forceinline__ void xcd_barrier(const XcdBarrier& b, const bool leader) {
    asm volatile("s_waitcnt vmcnt(0)" ::: "memory");
    __syncthreads();
    if (leader) {
        unsigned* bar = b.bar;
        __builtin_amdgcn_s_waitcnt(0);
        unsigned nloc = b.st[0], nx = b.st[1];
        if (nloc == 0u) { xcd_barrier_complete(bar, b.x, nloc, nx); b.st[0] = nloc; b.st[1] = nx; }
        const unsigned old = xb_add(&bar[XB_XSUB(b.x)], 1u);
        const unsigned gen = old / nloc;
        if (old + 1u == (gen + 1u) * nloc) {
            __builtin_amdgcn_fence(__ATOMIC_RELEASE, "agent");
            asm volatile("s_waitcnt vmcnt(0)" ::: "memory");
            const unsigned og = xb_add(&bar[XB_TOP], 1u);
            const unsigned tg = og / nx;
            if (og + 1u == (tg + 1u) * nx) xb_add(&bar[XB_TOPGEN], 1u);
            else XB_SPIN(xb_ld(&bar[XB_TOPGEN]) == tg, bar);
            __builtin_amdgcn_fence(__ATOMIC_ACQUIRE, "agent");
            xb_add(&bar[XB_XGEN(b.x)], 1u);
            asm volatile("s_waitcnt vmcnt(0)" ::: "memory");
        } else {
            XB_SPIN(xb_ld(&bar[XB_XGEN(b.x)]) == gen, bar);
            __builtin_amdgcn_fence(__ATOMIC_ACQUIRE, "agent");
            asm volatile("s_waitcnt vmcnt(0)" ::: "memory");
        }
    }
    __syncthreads();
}

namespace pg8 {
constexpr int BM = 256, BK = 64, HALF = 128, HTB = HALF * BK * 2, STAGE_BYTES = 8 * HTB, NXCD = 8, WGM = 4;
__host__ __device__ __forceinline__ int lds_byte(int r, int c) { const int st = (r >> 4) * 2 + (c >> 5), rr = r & 15, cc = c & 31, ob = rr * 64 + cc * 2; return st * 1024 + (ob ^ (((ob >> 9) & 1) << 5)); }
__host__ __device__ __forceinline__ void stage_rc(int b, int& R, int& C) { const int st = b / 1024, sb = b % 1024, swz = sb ^ (((sb >> 9) & 1) << 5); R = (st >> 1) * 16 + swz / 64; C = (st & 1) * 32 + (swz % 64) / 2; }
__host__ __device__ __forceinline__ int perm32(int rho) { const int n = rho >> 4, i = rho & 15; return 8 * (i >> 2) + 4 * n + (i & 3); }

struct Unit { int pm, pn, h, col0; };

struct GridSched {
    int nM, nN, nwg, G, c; const char* A; const char* Bt; size_t atile, btile;
    __device__ __forceinline__ void init(const void* A_, const void* Bt_, int M, int N, int lda, int ldb, int G_, int c_) {
        nM = M / BM; nN = N / BM; nwg = nM * nN; G = G_; c = c_; A = (const char*)A_; Bt = (const char*)Bt_; atile = (size_t)BM * lda * 2; btile = (size_t)BM * ldb * 2; }
    __device__ __forceinline__ bool next(int i, Unit& u) const {
        const long L = (long)i * G + c; if (L >= nwg) return false;
        int wgid = (int)L; { const int q = nwg / NXCD, r = nwg % NXCD, xcd = wgid % NXCD, off = wgid / NXCD; wgid = (xcd < r ? xcd * (q + 1) : r * (q + 1) + (xcd - r) * q) + off; }
        const int nig = WGM * nN, gid = wgid / nig, fm = gid * WGM, gsz = (nM - fm) < WGM ? (nM - fm) : WGM;
        u.pm = fm + ((wgid % nig) % gsz); u.pn = (wgid % nig) / gsz; u.h = 0; u.col0 = u.pn * BM; return true;
    }
    __device__ __forceinline__ const char* abase(const Unit& u) const { return A + (size_t)u.pm * atile; }
    __device__ __forceinline__ const char* bbase(const Unit& u) const { return Bt + (size_t)u.pn * btile; }
};
struct AttnSSched {
    int G, c; const char* Q; const char* KB;
    __device__ __forceinline__ bool next(int i, Unit& u) const { const int L = i * G + c; if (L >= 128) return false; const int x = L & 7, j = L >> 3; u.pm = 4 * x + (j >> 2); u.h = j & 3; u.pn = 0; u.col0 = u.h * 256; return true; }
    __device__ __forceinline__ const char* abase(const Unit& u) const { return Q + (size_t)u.pm * 256 * 2048 * 2; }
    __device__ __forceinline__ const char* bbase(const Unit& u) const { return KB + (size_t)u.h * 2048 * 2; }
};
struct MTSched {
    int L; const char* KB_; const char* WqN_;
    __device__ __forceinline__ bool next(int i, Unit& u) const { if (i > 0) return false; u.pm = 0; u.h = L >> 3; u.pn = L & 7; u.col0 = u.h * 2048 + u.pn * 256; return true; }
    __device__ __forceinline__ const char* abase(const Unit& u) const { return KB_ + (size_t)u.h * 512 * 2; }
    __device__ __forceinline__ const char* bbase(const Unit& u) const { return WqN_ + ((size_t)u.pn * 256 * 2048 + u.h * 512) * 2; }
};
struct NTSched {
    int L; const char* WxoT_; const char* VB_;
    __device__ __forceinline__ bool next(int i, Unit& u) const { if (i > 0) return false; u.pm = L & 7; u.h = L >> 3; u.pn = 0; u.col0 = u.h * 256; return true; }
    __device__ __forceinline__ const char* abase(const Unit& u) const { return WxoT_ + ((size_t)u.pm * 256 * 2048 + u.h * 512) * 2; }
    __device__ __forceinline__ const char* bbase(const Unit& u) const { return VB_ + (size_t)u.h * 512 * 2; }
};

struct EpiBf16 {
    static constexpr bool PERM = true, AFTER_DRAIN = false;
    bf16_t* O; int ldc;
    __device__ __forceinline__ void operator()(const f32x4 (&acc)[2][2][4][2], const Unit& u, int wr, int wc, int fr, int fq) const {
        const int row0 = u.pm * BM + wr * 64 + fr; const int col0 = u.col0 + wc * 32 + 8 * fq;
#pragma unroll
        for (int ai = 0; ai < 2; ++ai)
#pragma unroll
            for (int m = 0; m < 4; ++m) { bf16_t* rowp = O + (size_t)(row0 + ai * HALF + m * 16) * ldc + col0;
#pragma unroll
                for (int bj = 0; bj < 2; ++bj) { const f32x4 v0 = acc[ai][bj][m][0], v1 = acc[ai][bj][m][1];
                    u32x4 w; w.x = pk2(v0[0], v0[1]); w.y = pk2(v0[2], v0[3]); w.z = pk2(v1[0], v1[1]); w.w = pk2(v1[2], v1[3]);
                    *(u32x4*)(rowp + bj * HALF) = w; } }
    }
};
struct EpiKV {
    static constexpr bool PERM = false, AFTER_DRAIN = false;
    float* outk; float* outv; bf16_t* KB; bf16_t* VB;
    __device__ __forceinline__ void operator()(const f32x4 (&acc)[2][2][4][2], const Unit& u, int wr, int wc, int fr, int fq) const {
        const int row0 = u.pm * BM + wr * 64 + fr; const bool isk = u.pn < 8; const int col0 = (isk ? u.col0 : u.col0 - 2048) + wc * 32 + 4 * fq;
        float* ob = isk ? outk : outv;
#pragma unroll
        for (int ai = 0; ai < 2; ++ai)
#pragma unroll
            for (int m = 0; m < 4; ++m) { const size_t ro = (size_t)(row0 + ai * HALF + m * 16) * 2048 + col0;
#pragma unroll
                for (int bj = 0; bj < 2; ++bj)
#pragma unroll
                    for (int n = 0; n < 2; ++n) { const f32x4 v = acc[ai][bj][m][n]; *(f32x4*)(ob + ro + bj * HALF + n * 16) = v;
                        { u32x2 w; w.x = pk2(v[0], v[1]); w.y = pk2(v[2], v[3]); *(u32x2*)((isk ? KB : VB) + ro + bj * HALF + n * 16) = w; } } }
    }
};
struct EpiMix {
    static constexpr bool PERM = true, AFTER_DRAIN = false;
    const bf16_t* Z; bf16_t* MIX; int SECOND;
    __device__ __forceinline__ void operator()(const f32x4 (&acc)[2][2][4][2], const Unit& u, int wr, int wc, int fr, int fq) const {
        const int row0 = u.pm * BM + wr * 64 + fr; const int col0 = u.col0 + wc * 32 + 8 * fq;
#pragma unroll
        for (int ai = 0; ai < 2; ++ai) {
            u32x4 g[4][2], o[4][2];
#pragma unroll
            for (int m = 0; m < 4; ++m)
#pragma unroll
                for (int bj = 0; bj < 2; ++bj) { const int row = row0 + ai * HALF + m * 16;
                    g[m][bj] = *(const u32x4*)(Z + (size_t)row * NIN + (SECOND ? Z_GATEB : Z_GATEA) + col0 + bj * HALF);
                    if (SECOND) o[m][bj] = *(const u32x4*)(MIX + (size_t)row * D + col0 + bj * HALF); }
#pragma unroll
            for (int m = 0; m < 4; ++m)
#pragma unroll
                for (int bj = 0; bj < 2; ++bj) { const int row = row0 + ai * HALF + m * 16; const f32x4 a0 = acc[ai][bj][m][0], a1 = acc[ai][bj][m][1]; const u32x4 gg = g[m][bj];
                    float v[8];
                    v[0] = sigmoidf_(bf_lo(gg.x)) * a0[0]; v[1] = sigmoidf_(bf_hi(gg.x)) * a0[1]; v[2] = sigmoidf_(bf_lo(gg.y)) * a0[2]; v[3] = sigmoidf_(bf_hi(gg.y)) * a0[3];
                    v[4] = sigmoidf_(bf_lo(gg.z)) * a1[0]; v[5] = sigmoidf_(bf_hi(gg.z)) * a1[1]; v[6] = sigmoidf_(bf_lo(gg.w)) * a1[2]; v[7] = sigmoidf_(bf_hi(gg.w)) * a1[3];
                    if (SECOND) { const u32x4 oo = o[m][bj]; v[0] += bf_lo(oo.x); v[1] += bf_hi(oo.x); v[2] += bf_lo(oo.y); v[3] += bf_hi(oo.y); v[4] += bf_lo(oo.z); v[5] += bf_hi(oo.z); v[6] += bf_lo(oo.w); v[7] += bf_hi(oo.w); }
                    u32x4 w; w.x = pk2(v[0], v[1]); w.y = pk2(v[2], v[3]); w.z = pk2(v[4], v[5]); w.w = pk2(v[6], v[7]);
                    *(u32x4*)(MIX + (size_t)row * D + col0 + bj * HALF) = w; }
        }
    }
};
struct EpiSoftmax {
    static constexpr bool PERM = false, AFTER_DRAIN = true;
    bf16_t* P; int ldc; float sc; const float* rs;
    __device__ __forceinline__ void fused(f32x4 (&acc)[2][2][4][2], const Unit& u, int wr, int wc, int fr, int fq, LAS unsigned char* lds, int wid, int lane) const {
        LAS float* TM = (LAS float*)lds; LAS float* TS = (LAS float*)(lds + 4096);
#pragma unroll
        for (int ai = 0; ai < 2; ++ai)
#pragma unroll
            for (int m = 0; m < 4; ++m) { float mx = -3.0e38f; const float scr_ = sc * rs[u.pm * BM + ai * HALF + wr * 64 + m * 16 + fr];
#pragma unroll
                for (int bj = 0; bj < 2; ++bj)
#pragma unroll
                    for (int n = 0; n < 2; ++n) { f32x4 v = acc[ai][bj][m][n] * scr_; acc[ai][bj][m][n] = v; mx = fmaxf(mx, fmaxf(fmaxf(v[0], v[1]), fmaxf(v[2], v[3]))); }
                mx = fmaxf(mx, __shfl_xor(mx, 16)); mx = fmaxf(mx, __shfl_xor(mx, 32));
                if (fq == 0) TM[(ai * HALF + wr * 64 + m * 16 + fr) * 4 + wc] = mx; }
        LDS_WAIT(); __builtin_amdgcn_s_barrier(); asm volatile("" ::: "memory");
#pragma unroll
        for (int ai = 0; ai < 2; ++ai)
#pragma unroll
            for (int m = 0; m < 4; ++m) { const int r = ai * HALF + wr * 64 + m * 16 + fr; const f32x4 t = *(const LAS f32x4*)(TM + r * 4);
                const float mx = fmaxf(fmaxf(t[0], t[1]), fmaxf(t[2], t[3])); float s = 0.f;
#pragma unroll
                for (int bj = 0; bj < 2; ++bj)
#pragma unroll
                    for (int n = 0; n < 2; ++n) { f32x4 v = acc[ai][bj][m][n];
                        v[0] = __builtin_amdgcn_exp2f(v[0] - mx); v[1] = __builtin_amdgcn_exp2f(v[1] - mx); v[2] = __builtin_amdgcn_exp2f(v[2] - mx); v[3] = __builtin_amdgcn_exp2f(v[3] - mx);
                        acc[ai][bj][m][n] = v; s += (v[0] + v[1]) + (v[2] + v[3]); }
                s += __shfl_xor(s, 16); s += __shfl_xor(s, 32);
                if (fq == 0) TS[r * 4 + wc] = s; }
        LDS_WAIT(); __builtin_amdgcn_s_barrier(); asm volatile("" ::: "memory");
#pragma unroll
        for (int ai = 0; ai < 2; ++ai)
#pragma unroll
            for (int m = 0; m < 4; ++m) { const int r = ai * HALF + wr * 64 + m * 16 + fr; const f32x4 t = *(const LAS f32x4*)(TS + r * 4);
                const float inv = 1.0f / ((t[0] + t[1]) + (t[2] + t[3]));
                bf16_t* rowp = P + (size_t)(u.pm * BM + r) * ldc + u.col0 + wc * 32 + 4 * fq;
#pragma unroll
                for (int bj = 0; bj < 2; ++bj)
#pragma unroll
                    for (int n = 0; n < 2; ++n) { const f32x4 v = acc[ai][bj][m][n] * inv; u32x2 w; w.x = pk2(v[0], v[1]); w.y = pk2(v[2], v[3]); *(u32x2*)(rowp + bj * HALF + n * 16) = w; } }
    }
};

template <class Epi, class Sched>
__device__ __forceinline__ void gemm_phase(LAS unsigned char* lds, const Sched& S, const Epi& E, const int K, const int lda, const int ldb, const int tid) {
    constexpr bool ALIGN_EPI = !Epi::AFTER_DRAIN;
    const int wid = __builtin_amdgcn_readfirstlane(tid >> 6), lane = tid & 63, wr = wid >> 2, wc = wid & 3, fr = lane & 15, fq = lane >> 4;
    const int nt = K / BK;
    unsigned voffA[2], voffB[2];
#pragma unroll
    for (int i = 0; i < 2; ++i) { int R, C; stage_rc(tid * 16 + i * 8192, R, C); const int Rb = Epi::PERM ? ((R & ~31) + perm32(R & 31)) : R;
        voffA[i] = (unsigned)(R * lda + C) * 2u; voffB[i] = (unsigned)(Rb * ldb + C) * 2u; }
    const size_t kstep = (size_t)(BK * 2);
    const size_t hstepA = (size_t)HALF * lda * 2, hstepB = (size_t)HALF * ldb * 2;
    const unsigned ldsw = (unsigned)wid * 1024u;
    const int aoff = lds_byte(wr * 64 + fr, fq * 8), boff = lds_byte(wc * 32 + fr, fq * 8);
#define PG8_SA(b, h) (((b) * 2 + (h)) * HTB)
#define PG8_SB(b, h) ((4 + (b) * 2 + (h)) * HTB)
#define PG8_STAGE(bufoff, gbase, voff) do { _Pragma("unroll") for (int _i = 0; _i < 2; ++_i) \
        __builtin_amdgcn_global_load_lds((const unsigned*)((const char*)(gbase) + (voff)[_i]), (LAS unsigned*)(lds + (bufoff) + ldsw + _i * 8192), 16, 0, 0); } while (0)
#define PG8_LDA(dst, b, h) do { _Pragma("unroll") for (int m = 0; m < 4; ++m) _Pragma("unroll") for (int k = 0; k < 2; ++k) dst[m][k] = *(const LAS bf16x8*)(lds + PG8_SA(b, h) + aoff + m * 2048 + k * 1024); } while (0)
#define PG8_LDB(dst, b, h) do { _Pragma("unroll") for (int n = 0; n < 2; ++n) _Pragma("unroll") for (int k = 0; k < 2; ++k) dst[n][k] = *(const LAS bf16x8*)(lds + PG8_SB(b, h) + boff + n * 2048 + k * 1024); } while (0)
#define PG8_MMA(ai, bj, At, Bt) do { __builtin_amdgcn_s_setprio(1); _Pragma("unroll") for (int m = 0; m < 4; ++m) _Pragma("unroll") for (int n = 0; n < 2; ++n) _Pragma("unroll") for (int k = 0; k < 2; ++k) \
        acc[ai][bj][m][n] = __builtin_amdgcn_mfma_f32_16x16x32_bf16(Bt[n][k], At[m][k], acc[ai][bj][m][n], 0, 0, 0); __builtin_amdgcn_s_setprio(0); } while (0)
#define PG8_WAIT_V(n) asm volatile("s_waitcnt vmcnt(" #n ")" ::: "memory")
#define PG8_WAIT_L(n) asm volatile("s_waitcnt lgkmcnt(" #n ")" ::: "memory")
#define PG8_BAR __builtin_amdgcn_s_barrier()
#define PG8_SCHED __builtin_amdgcn_sched_barrier(0)
    Unit cur, nxt; int ui = 0;
    if (!S.next(0, cur)) return;
    f32x4 acc[2][2][4][2];
#pragma unroll
    for (int a = 0; a < 2; ++a)
#pragma unroll
        for (int b = 0; b < 2; ++b)
#pragma unroll
            for (int m = 0; m < 4; ++m)
#pragma unroll
                for (int n = 0; n < 2; ++n) acc[a][b][m][n] = (f32x4){0.f, 0.f, 0.f, 0.f};
    bf16x8 At[4][2], B0[2][2], B1[2][2];
    const char* cA = S.abase(cur); const char* cB = S.bbase(cur);
    PG8_STAGE(PG8_SB(0, 0), cB, voffB); PG8_STAGE(PG8_SB(0, 1), cB + hstepB, voffB); PG8_STAGE(PG8_SA(0, 0), cA, voffA); PG8_STAGE(PG8_SA(0, 1), cA + hstepA, voffA);
    if (wr == 1) PG8_BAR;
    PG8_WAIT_V(2); PG8_BAR;
    PG8_STAGE(PG8_SB(1, 0), cB + kstep, voffB); PG8_STAGE(PG8_SA(1, 0), cA + kstep, voffA); PG8_STAGE(PG8_SB(1, 1), cB + hstepB + kstep, voffB);
    PG8_WAIT_V(6); PG8_BAR;
    for (;;) {
        const bool has_next = S.next(ui + 1, nxt);
        const char* nA = has_next ? S.abase(nxt) : cA; const char* nB = has_next ? S.bbase(nxt) : cB;
        for (int t = 0; t < nt; t += 2) {
            const bool last = (t == nt - 2);
            const char* a1 = cA + (size_t)(t + 1) * kstep;
            const char* a2 = last ? nA : cA + (size_t)(t + 2) * kstep; const char* b2 = last ? nB : cB + (size_t)(t + 2) * kstep;
            const char* a3 = a2 + kstep; const char* b3 = b2 + kstep;
            PG8_LDB(B0, 0, 0); PG8_LDB(B1, 0, 1); PG8_SCHED; PG8_LDA(At, 0, 0); PG8_STAGE(PG8_SA(1, 1), a1 + hstepA, voffA);
            PG8_WAIT_V(8); PG8_WAIT_L(0); PG8_BAR; PG8_MMA(0, 0, At, B0); PG8_MMA(0, 1, At, B1); PG8_BAR; PG8_SCHED;
            PG8_LDA(At, 0, 1); PG8_STAGE(PG8_SB(0, 0), b2, voffB); PG8_STAGE(PG8_SB(0, 1), b2 + hstepB, voffB); PG8_STAGE(PG8_SA(0, 0), a2, voffA);
            PG8_WAIT_V(8); PG8_WAIT_L(0); PG8_BAR; PG8_MMA(1, 0, At, B0); PG8_MMA(1, 1, At, B1); PG8_BAR; PG8_SCHED;
            PG8_LDB(B0, 1, 0); PG8_LDB(B1, 1, 1); PG8_SCHED; PG8_LDA(At, 1, 0); PG8_STAGE(PG8_SA(0, 1), a2 + hstepA, voffA);
            PG8_WAIT_V(8); PG8_WAIT_L(0); PG8_BAR; PG8_MMA(0, 0, At, B0); PG8_MMA(0, 1, At, B1); PG8_BAR; PG8_SCHED;
            PG8_LDA(At, 1, 1); PG8_STAGE(PG8_SB(1, 0), b3, voffB); PG8_STAGE(PG8_SB(1, 1), b3 + hstepB, voffB); PG8_STAGE(PG8_SA(1, 0), a3, voffA);
            PG8_WAIT_V(8); PG8_WAIT_L(0); PG8_BAR; PG8_MMA(1, 0, At, B0); PG8_MMA(1, 1, At, B1); PG8_BAR; PG8_SCHED;
        }
        if constexpr (ALIGN_EPI) { if (wr == 0) PG8_BAR; }
        if constexpr (!Epi::AFTER_DRAIN) { E(acc, cur, wr, wc, fr, fq); }
        if (!has_next) break;
#pragma unroll
        for (int a = 0; a < 2; ++a)
#pragma unroll
            for (int b = 0; b < 2; ++b)
#pragma unroll
                for (int m = 0; m < 4; ++m)
#pragma unroll
                    for (int n = 0; n < 2; ++n) acc[a][b][m][n] = (f32x4){0.f, 0.f, 0.f, 0.f};
        cur = nxt; cA = nA; cB = nB; ++ui;
        if constexpr (ALIGN_EPI) { if (wr == 1) PG8_BAR; }
    }
    PG8_WAIT_V(0);
    if constexpr (!ALIGN_EPI) { if (wr == 0) PG8_BAR; }
    PG8_BAR;
    if constexpr (Epi::AFTER_DRAIN) { E.fused(acc, cur, wr, wc, fr, fq, lds, wid, lane); }
#undef PG8_SA
#undef PG8_SB
#undef PG8_STAGE
#undef PG8_LDA
#undef PG8_LDB
#undef PG8_MMA
#undef PG8_WAIT_V
#undef PG8_WAIT_L
#undef PG8_BAR
#undef PG8_SCHED
}
}

__device__ __forceinline__ void transpose_item(const float* W, int K, int N, bf16_t* WT, LAS float* scr, int item, int lane) {
    const int nblk = N / 64, kb = item / nblk, nb = item % nblk, k0 = 64 * kb, n0 = 64 * nb;
    f32x4 v[16];
#pragma unroll
    for (int i = 0; i < 16; ++i) v[i] = __builtin_nontemporal_load((const f32x4*)(W + (size_t)(k0 + 4 * i + (lane >> 4)) * N + n0 + 4 * (lane & 15)));
#pragma unroll
    for (int i = 0; i < 16; ++i) { LAS float* d = scr + (4 * i + (lane >> 4)) * 65 + 4 * (lane & 15); d[0] = v[i][0]; d[1] = v[i][1]; d[2] = v[i][2]; d[3] = v[i][3]; }
    LDS_WAIT(); asm volatile("" ::: "memory");
    const int c = lane & 7;
#pragma unroll
    for (int j = 0; j < 8; ++j) { const int n = (lane >> 3) + 8 * j; const LAS float* s = scr + (8 * c) * 65 + n;
        u32x4 o; o.x = pk2h(s[0 * 65], s[1 * 65]); o.y = pk2h(s[2 * 65], s[3 * 65]); o.z = pk2h(s[4 * 65], s[5 * 65]); o.w = pk2h(s[6 * 65], s[7 * 65]);
        *(u32x4*)(WT + (size_t)(n0 + n) * K + k0 + 8 * c) = o; }
    LDS_WAIT(); asm volatile("" ::: "memory");
}
__device__ __forceinline__ void rms_row_bf16(const float* xrow, const float* g, bf16_t* urow, int lane) {
    f32x4 v[8]; float ss = 0.f;
#pragma unroll
    for (int j = 0; j < 4; ++j) { v[2 * j] = *(const f32x4*)(xrow + j * 512 + lane * 8); v[2 * j + 1] = *(const f32x4*)(xrow + j * 512 + lane * 8 + 4); }
#pragma unroll
    for (int j = 0; j < 8; ++j) ss += (v[j][0] * v[j][0] + v[j][1] * v[j][1]) + (v[j][2] * v[j][2] + v[j][3] * v[j][3]);
    const float r = rsqrtf(wave_sum(ss) * (1.0f / D) + EPS);
#pragma unroll
    for (int j = 0; j < 4; ++j) { const f32x4 g0 = *(const f32x4*)(g + j * 512 + lane * 8), g1 = *(const f32x4*)(g + j * 512 + lane * 8 + 4); const f32x4 a = v[2 * j] * r * g0, b = v[2 * j + 1] * r * g1;
        u32x4 w; w.x = pk2h(a[0], a[1]); w.y = pk2h(a[2], a[3]); w.z = pk2h(b[0], b[1]); w.w = pk2h(b[2], b[3]); *(u32x4*)(urow + j * 512 + lane * 8) = w; }
}
template <bool SECOND, int XMODE, int UMODE = 0>
__device__ __forceinline__ void row_pass(const bf16_t* trow, const void* xrow_, void* orow_, const float* gpost, const float* gpre, bf16_t* urow, int lane, float* rsout = nullptr) {
    f32x4 t[8]; float ss = 0.f;
#pragma unroll
    for (int j = 0; j < 4; ++j) { const u32x4 w = *(const u32x4*)(trow + j * 512 + lane * 8);
        t[2 * j] = (f32x4){bf_lo(w.x), bf_hi(w.x), bf_lo(w.y), bf_hi(w.y)}; t[2 * j + 1] = (f32x4){bf_lo(w.z), bf_hi(w.z), bf_lo(w.w), bf_hi(w.w)}; }
#pragma unroll
    for (int j = 0; j < 8; ++j) ss += (t[j][0] * t[j][0] + t[j][1] * t[j][1]) + (t[j][2] * t[j][2] + t[j][3] * t[j][3]);
    const float r = rsqrtf(wave_sum(ss) * (1.0f / D) + EPS);
    float ss2 = 0.f;
#pragma unroll
    for (int jj = 0; jj < 4; ++jj) { const int off = jj * 512 + lane * 8; f32x4 x0, x1;
        if (XMODE & 2) { const u32x4 w = *(const u32x4*)((const bf16_t*)xrow_ + off); x0 = (f32x4){bf_lo(w.x), bf_hi(w.x), bf_lo(w.y), bf_hi(w.y)}; x1 = (f32x4){bf_lo(w.z), bf_hi(w.z), bf_lo(w.w), bf_hi(w.w)}; }
        else { x0 = *(const f32x4*)((const float*)xrow_ + off); x1 = *(const f32x4*)((const float*)xrow_ + off + 4); }
        const f32x4 g0 = *(const f32x4*)(gpost + off), g1 = *(const f32x4*)(gpost + off + 4);
        const f32x4 a = x0 + t[2 * jj] * r * g0, b = x1 + t[2 * jj + 1] * r * g1; t[2 * jj] = a; t[2 * jj + 1] = b;
        if (XMODE & 1) { u32x4 w; w.x = pk2h(a[0], a[1]); w.y = pk2h(a[2], a[3]); w.z = pk2h(b[0], b[1]); w.w = pk2h(b[2], b[3]); *(u32x4*)((bf16_t*)orow_ + off) = w; }
        else { *(f32x4*)((float*)orow_ + off) = a; *(f32x4*)((float*)orow_ + off + 4) = b; }
        ss2 += (a[0] * a[0] + a[1] * a[1]) + (a[2] * a[2] + a[3] * a[3]) + (b[0] * b[0] + b[1] * b[1]) + (b[2] * b[2] + b[3] * b[3]); }
    if (SECOND) {
        const float r2 = rsqrtf(wave_sum(ss2) * (1.0f / D) + EPS);
        if (UMODE == 1) { if (lane == 0) *rsout = r2; return; }
#pragma unroll
        for (int j = 0; j < 4; ++j) { const f32x4 g0 = *(const f32x4*)(gpre + j * 512 + lane * 8), g1 = *(const f32x4*)(gpre + j * 512 + lane * 8 + 4); const f32x4 a = t[2 * j] * r2 * g0, b = t[2 * j + 1] * r2 * g1;
            u32x4 w; w.x = pk2h(a[0], a[1]); w.y = pk2h(a[2], a[3]); w.z = pk2h(b[0], b[1]); w.w = pk2h(b[2], b[3]); *(u32x4*)(urow + j * 512 + lane * 8) = w; }
    }
}


__device__ __forceinline__ void final_row_pass(const bf16_t* trow, float* slot, const float* gpost, int lane) {
    u32x4 tw[4], xw[4];
#pragma unroll
    for (int j = 0; j < 4; ++j) { tw[j] = *(const u32x4*)(trow + j * 512 + lane * 8); xw[j] = *(const u32x4*)((const bf16_t*)slot + D + j * 512 + lane * 8); }
    asm volatile("s_waitcnt vmcnt(0)" ::: "memory");
    float ss = 0.f;
#pragma unroll
    for (int j = 0; j < 4; ++j) { const u32x4 w = tw[j]; const float a0 = bf_lo(w.x), a1 = bf_hi(w.x), a2 = bf_lo(w.y), a3 = bf_hi(w.y), a4 = bf_lo(w.z), a5 = bf_hi(w.z), a6 = bf_lo(w.w), a7 = bf_hi(w.w);
        ss += (a0 * a0 + a1 * a1) + (a2 * a2 + a3 * a3) + (a4 * a4 + a5 * a5) + (a6 * a6 + a7 * a7); }
    const float r = rsqrtf(wave_sum(ss) * (1.0f / D) + EPS);
#pragma unroll
    for (int j = 0; j < 4; ++j) { const int off = j * 512 + lane * 8; const u32x4 w = tw[j], x = xw[j];
        const f32x4 g0 = *(const f32x4*)(gpost + off), g1 = *(const f32x4*)(gpost + off + 4);
        const f32x4 t0 = (f32x4){bf_lo(w.x), bf_hi(w.x), bf_lo(w.y), bf_hi(w.y)}, t1 = (f32x4){bf_lo(w.z), bf_hi(w.z), bf_lo(w.w), bf_hi(w.w)};
        const f32x4 x0 = (f32x4){bf_lo(x.x), bf_hi(x.x), bf_lo(x.y), bf_hi(x.y)}, x1 = (f32x4){bf_lo(x.z), bf_hi(x.z), bf_lo(x.w), bf_hi(x.w)};
        *(f32x4*)(slot + off) = x0 + t0 * r * g0; *(f32x4*)(slot + off + 4) = x1 + t1 * r * g1; }
}

template <int KC>
__device__ __forceinline__ f32x16 thin_mac_lds(LAS unsigned char* lds, const bf16_t* A, const bf16_t* Bt, int K, int tid, int wid, int lane) {
    constexpr int NP = KC / 128, SH = (KC == 1024) ? 7 : 6, RS = 2 * KC + 16;
    LAS unsigned char* LA = lds; LAS unsigned char* LB = lds + 32 * RS;
    const int r = lane & 31, hh = lane >> 5;
    f32x16 acc;
#pragma unroll
    for (int e = 0; e < 16; ++e) acc[e] = 0.f;
    u32x4 ra[NP], rb[NP];
    const int prow = tid >> SH, pc8 = tid & ((1 << SH) - 1);
    const bf16_t* ga = A + (size_t)prow * K + pc8 * 8; const bf16_t* gb = Bt + (size_t)prow * K + pc8 * 8;
    const size_t gstep = (size_t)(512 >> SH) * K;
#pragma unroll
    for (int i = 0; i < NP; ++i) { ra[i] = *(const u32x4*)(ga + i * gstep); rb[i] = *(const u32x4*)(gb + i * gstep); }
    for (int k0 = 0; k0 < K; k0 += KC) {
        __syncthreads();
#pragma unroll
        for (int i = 0; i < NP; ++i) { const int row = prow + i * (512 >> SH); *(LAS u32x4*)(LA + row * RS + pc8 * 16) = ra[i]; *(LAS u32x4*)(LB + row * RS + pc8 * 16) = rb[i]; }
        __syncthreads();
        if (k0 + KC < K) {
#pragma unroll
            for (int i = 0; i < NP; ++i) { ra[i] = *(const u32x4*)(ga + i * gstep + k0 + KC); rb[i] = *(const u32x4*)(gb + i * gstep + k0 + KC); } }
        const int ks = wid * (KC / 8);
#pragma unroll
        for (int s2 = 0; s2 < KC / 128; ++s2) { const bf16x8 a = *(const LAS bf16x8*)(LA + r * RS + (ks + 16 * s2 + 8 * hh) * 2), b = *(const LAS bf16x8*)(LB + r * RS + (ks + 16 * s2 + 8 * hh) * 2);
            acc = __builtin_amdgcn_mfma_f32_32x32x16_bf16(a, b, acc, 0, 0, 0); }
    }
    return acc;
}
__device__ __forceinline__ void thin_put(LAS float* red, const f32x16& acc, int wid, int lane) {
    const int col = lane & 31, hh = lane >> 5;
#pragma unroll
    for (int e = 0; e < 16; ++e) red[wid * 1024 + ((e & 3) + 8 * (e >> 2) + 4 * hh) * 32 + col] = acc[e];
}
__device__ __forceinline__ void thin_get(const LAS float* red, int tid, float& v0, float& v1) {
    const int o = (tid >> 4) * 32 + (tid & 15) * 2; v0 = 0.f; v1 = 0.f;
#pragma unroll
    for (int w = 0; w < 8; ++w) { v0 += red[w * 1024 + o]; v1 += red[w * 1024 + o + 1]; }
}
template <int KC>
__device__ __forceinline__ void thin_gemm_bf16(LAS unsigned char* lds, const bf16_t* A, const bf16_t* Bt, int K, bf16_t* O, int c, int tid, int wid, int lane) {
    const int r0 = SEQ + 32 * ((c >> 3) & 3), c0 = 32 * (8 * (c & 7) + (c >> 5)), kw = K / 8;
    LAS float* red = (LAS float*)lds;
    const f32x16 acc = thin_mac_lds<KC>(lds, A + (size_t)r0 * K, Bt + (size_t)c0 * K, K, tid, wid, lane); (void)kw;
    __syncthreads();
    thin_put(red, acc, wid, lane);
    __syncthreads();
    float v0, v1; thin_get(red, tid, v0, v1);
    *(unsigned*)(O + (size_t)(r0 + (tid >> 4)) * D + c0 + (tid & 15) * 2) = pk2(v0, v1);
    __syncthreads();
}

__global__ void __launch_bounds__(512, 2) mega(Params p) {
    extern __shared__ __attribute__((aligned(16))) unsigned char lds_raw[];
    LAS unsigned char* lds = (LAS unsigned char*)lds_raw;
    cg::grid_group grid = cg::this_grid();
    const int wid0_ = __builtin_amdgcn_readfirstlane((int)(threadIdx.x >> 6));
#define IN(k) (p.ph_lo <= (k) && (k) < p.ph_hi)
#define PHASE_VARS int tid = (wid0_ << 6) | lane_id_(); asm volatile("" : "+v"(tid)); const int lane = tid & 63, wid = __builtin_amdgcn_readfirstlane(tid >> 6), c = blockIdx.x, G = gridDim.x; const int gw = c * 8 + wid, NGW = G * 8; (void)lane; (void)gw; (void)NGW;
#if USE_XCD_BAR
    volatile LAS unsigned* bst = (volatile LAS unsigned*)(lds + LDS_BYTES - 16);
    if (threadIdx.x < 4) bst[threadIdx.x] = 0u;
    __syncthreads();
    XcdBarrier xbar = xcd_barrier_post((unsigned*)(p.ws + WS_BAR), bst);
#define SEAM(k) do { if (IN(k) && IN((k) + 1)) { xcd_barrier(xbar, ((wid0_ << 6) | lane_id_()) == 0); } } while (0)
#else
#define SEAM(k) do { if (IN(k) && IN((k) + 1)) grid.sync(); } while (0)
#endif
#define out (p.out)
#define WSP(off) ((bf16_t*)(p.ws + (off)))
#define WinT WSP(WS_WIN)
#define WkvT WSP(WS_WKV)
#define WpaT WSP(WS_WPA)
#define WpbT WSP(WS_WPB)
#define WoT WSP(WS_WO)
#define WqT WSP(WS_WQ)
#define WxoT WSP(WS_WXO)
#define WrT WSP(WS_WR)
#define WiT WSP(WS_WI)
#define WupT WSP(WS_T)
#define WdnT WSP(WS_WDN)
#define KB WSP(WS_KB)
#define VB WSP(WS_VT)
#define NT WSP(WS_END)
#define WqN WSP(WS_END + 4194304)
#define MT WSP(WS_END + 12582912)
#define RS1 ((float*)(p.ws + WS_END + 16777216))
#define MN WSP(WS_MN)
#define PSP ((float*)(p.ws + WS_PSP))
#define PSS ((float*)(p.ws + WS_PSS))
#define PS2 ((unsigned long long*)(p.ws + WS_PSP))
#define FLG ((unsigned*)(p.ws + WS_BAR + 16384))
#define Z WSP(WS_Z)
#define UP WSP(WS_Z)
#define X1B WSP(WS_Z)
#define T WSP(WS_T)
#define U WSP(B1)
#define HLOC WSP(B1)
#define MIX WSP(B1)
#define Qb WSP(B1)
#define CP WSP(B2)
#define U2 WSP(B2)
#define Ob WSP(B2)
#define HA WSP(B3)
#define Pb WSP(B3)
#define HBb WSP(B4)
#define U3 WSP(B1)
#define T2 WSP(B3)
#define Gb WSP(WS_G)
    if (IN(0)) { PHASE_VARS
        LAS float* scr = (LAS float*)(lds + wid * 16896);
        constexpr int I_IN = 32 * 176, I_SQ = 32 * 32, I_PB = 16 * 32, I_BD = 64;
        constexpr int NIT = I_IN + 2 * I_SQ + 2 * I_BD;
        for (int it = gw; it < NIT; it += NGW) {
            int r = it;
            if (r < I_IN) { transpose_item(p.in[11], D, NIN, WinT, scr, r, lane); continue; } r -= I_IN;
            if (r < I_SQ) { transpose_item(p.in[27], D, D, WkvT, scr, r, lane); continue; } r -= I_SQ;
            if (r < I_SQ) { transpose_item(p.in[28], D, D, WkvT + (size_t)D * D, scr, r, lane); continue; } r -= I_SQ;
            if (r < I_BD) { const int hh = r >> 2; transpose_item(p.in[14] + hh * 16384, 128, 128, WrT + hh * 16384, scr, r & 3, lane); continue; } r -= I_BD;
            { const int hh = r >> 2; transpose_item(p.in[16] + hh * 16384, 128, 128, WiT + hh * 16384, scr, r & 3, lane); }
        }
        for (int m = gw; m < MP + NMEM; m += NGW) {
            if (m < SEQ) rms_row_bf16(p.in[0] + (size_t)m * D, p.in[9], U + (size_t)m * D, lane);
            else if (m < MR) rms_row_bf16(p.in[1] + (size_t)(m - SEQ) * D, p.in[9], U + (size_t)m * D, lane);
            else if (m < MP) {
#pragma unroll
                for (int j = 0; j < 4; ++j) *(u32x4*)(U + (size_t)m * D + j * 512 + lane * 8) = (u32x4){0u, 0u, 0u, 0u}; }
            else rms_row_bf16(p.in[2] + (size_t)(m - MP) * D, p.in[25], MN + (size_t)(m - MP) * D, lane);
        }
    }
    SEAM(0);
    if (IN(1)) { PHASE_VARS
        { pg8::GridSched S; S.init(U, WinT, MP, NIN, D, D, G, c); pg8::EpiBf16 E{Z, NIN}; pg8::gemm_phase(lds, S, E, D, D, D, tid); }
        { pg8::GridSched S; S.init(MN, WkvT, NMEM, 2 * D, D, D, G, (c + G - 172) % G); pg8::EpiKV E{out + O_PMK, out + O_PMV, KB, VB}; pg8::gemm_phase(lds, S, E, D, D, D, tid); }
        if (c >= 196) {
            __syncthreads();
            LAS float* scr = (LAS float*)(lds + wid * 16896);
            constexpr int I_SQ = 32 * 32, I_PB = 16 * 32;
            for (int it = (c - 196) * 8 + wid; it < 4 * I_SQ + I_PB; it += (G - 196) * 8) {
                int r = it;
                if (r < I_SQ) { transpose_item(p.in[20], D, D, WpaT, scr, r, lane); continue; } r -= I_SQ;
                if (r < I_SQ) { transpose_item(p.in[22], D, D, WoT, scr, r, lane); continue; } r -= I_SQ;
                if (r < I_SQ) { transpose_item(p.in[26], D, D, WqT, scr, r, lane); continue; } r -= I_SQ;
                if (r < I_SQ) { transpose_item(p.in[29], D, D, WxoT, scr, r, lane); continue; } r -= I_SQ;
                transpose_item(p.in[21], DC, D, WpbT, scr, r, lane);
            }
            {
                const float* wq = p.in[26];
                for (int i = (c - 196) * 8 + wid; i < D * D / 512; i += (G - 196) * 8) { const float gq_ = p.in[23][i >> 2]; const f32x4 a = gq_ * __builtin_nontemporal_load((const f32x4*)(wq + (size_t)i * 512 + lane * 8)), b = gq_ * __builtin_nontemporal_load((const f32x4*)(wq + (size_t)i * 512 + lane * 8 + 4));
                    u32x4 w; w.x = pk2h(a[0], a[1]); w.y = pk2h(a[2], a[3]); w.z = pk2h(b[0], b[1]); w.w = pk2h(b[2], b[3]); *(u32x4*)(WqN + (size_t)i * 512 + lane * 8) = w; }
            }
        }
    }
    SEAM(1);
    if (IN(2)) { PHASE_VARS
        {
            const int h = c & 15;
            LAS unsigned char* WR = lds; LAS unsigned char* WI = lds + 34816; LAS unsigned char* XA = lds + 69632;
            LAS float* Ab = (LAS float*)(lds + 87040); LAS float* Bb = (LAS float*)(lds + 87040 + 32768);
            LAS float* SEGP = (LAS float*)(lds + 69632); LAS float* SEGS = (LAS float*)(lds + 69632 + 2048);
            for (int q = tid; q < 2048; q += 512) { const int j = q >> 4, ck = q & 15;
                *(LAS u32x4*)(WR + j * 272 + ck * 16) = *(const u32x4*)(WrT + h * 16384 + j * 128 + ck * 8);
                *(LAS u32x4*)(WI + j * 272 + ck * 16) = *(const u32x4*)(WiT + h * 16384 + j * 128 + ck * 8); }
            const int i2 = tid & 63, tg = tid >> 6, chc = h * 128 + 2 * i2;
            float cw[4][2];
#pragma unroll
            for (int k = 0; k < 4; ++k) { cw[k][0] = p.in[12][k * D + chc]; cw[k][1] = p.in[12][k * D + chc + 1]; }
            const float cb0 = p.in[13][chc], cb1 = p.in[13][chc + 1];
            const int mb = wid & 1, nb = wid >> 1, l31 = lane & 31, hh = lane >> 5, jg = 32 * nb + l31, chg = h * 128 + jg;
            const float br = p.in[15][chg], bi = p.in[17][chg];
            const float sp8 = -8.0f * log1pf(__expf(-p.in[18][chg]));
            const int seg = tid >> 7, sch = tid & 127, schg = h * 128 + sch;
            unsigned zr[11];
#define ZR_ISSUE(ccn) do { _Pragma("unroll") for (int k = 0; k < 11; ++k) { const int grow = (ccn) * 64 + tg * 8 - 3 + k; zr[k] = grow >= 0 ? *(const unsigned*)(Z + (size_t)grow * NIN + chc) : 0u; } } while (0)
            if ((c >> 4) < 128) ZR_ISSUE(c >> 4);
            float carry_run = 0.f;
            LAS float* CARR = (LAS float*)(lds + 69632 + 4096);
            for (int cc = c >> 4; cc < NCHUNK; cc += 16) {
                const int r0 = cc * 64; const bool smp = cc >= 128;
                __syncthreads();
                {
                    float ra[11], rb[11]; const int t0 = tg * 8;
                    if (!smp) {
#pragma unroll
                        for (int k = 0; k < 11; ++k) { ra[k] = bf_lo(zr[k]); rb[k] = bf_hi(zr[k]); }
                        if (cc + 16 < 128) ZR_ISSUE(cc + 16);
                    } else {
#pragma unroll
                        for (int k = 0; k < 11; ++k) { const int pp = (t0 & 15) - 3 + k, b = (r0 - SEQ + t0) >> 4;
                            if (pp >= 0) { const unsigned u = *(const unsigned*)(Z + (size_t)(SEQ + b * 16 + pp) * NIN + chc); ra[k] = bf_lo(u); rb[k] = bf_hi(u); }
                            else { const float* sp = p.in[3] + (size_t)(b * 3 + 3 + pp) * D + chc; ra[k] = sp[0]; rb[k] = sp[1]; } }
                    }
#pragma unroll
                    for (int j = 0; j < 8; ++j) { const float o0 = cb0 + cw[0][0] * ra[j] + cw[1][0] * ra[j + 1] + cw[2][0] * ra[j + 2] + cw[3][0] * ra[j + 3];
                        const float o1 = cb1 + cw[0][1] * rb[j] + cw[1][1] * rb[j + 1] + cw[2][1] * rb[j + 2] + cw[3][1] * rb[j + 3];
                        *(LAS unsigned*)(XA + (t0 + j) * 272 + i2 * 4) = pk2h(o0, o1); }
                }
                __syncthreads();
                {
                    f32x16 accR, accI;
#pragma unroll
                    for (int e = 0; e < 16; ++e) { accR[e] = 0.f; accI[e] = 0.f; }
#pragma unroll
                    for (int kk = 0; kk < 8; ++kk) {
                        const bf16x8 a = *(const LAS bf16x8*)(XA + (32 * mb + l31) * 272 + (16 * kk + 8 * hh) * 2);
                        const bf16x8 b0 = *(const LAS bf16x8*)(WR + (32 * nb + l31) * 272 + (16 * kk + 8 * hh) * 2);
                        const bf16x8 b1 = *(const LAS bf16x8*)(WI + (32 * nb + l31) * 272 + (16 * kk + 8 * hh) * 2);
                        accR = __builtin_amdgcn_mfma_f32_32x32x16_bf16(a, b0, accR, 0, 0, 0);
                        accI = __builtin_amdgcn_mfma_f32_32x32x16_bf16(a, b1, accI, 0, 0, 0);
                    }
#pragma unroll
                    for (int e = 0; e < 16; ++e) { const int t = 32 * mb + (e & 3) + 8 * (e >> 2) + 4 * hh;
                        const float rr = sigmoidf_(accR[e] + br), ii = sigmoidf_(accI[e] + bi);
                        const float la = sp8 * rr; const float a = __expf(la); float mult = __builtin_amdgcn_sqrtf(1.0f - a * a);
                        if (r0 + t == 0) mult = 1.0f;
                        const float xv = bf1(*(const LAS bf16_t*)(XA + t * 272 + jg * 2));
                        Ab[t * 128 + jg] = a; Bb[t * 128 + jg] = mult * ii * xv; }
                }
                const bf16_t* gap_ = Z + (size_t)(r0 + (tid >> 3)) * NIN + Z_GA + h * 128 + (tid & 7) * 16;
                const u32x4 gq0 = *(const u32x4*)gap_, gq1 = *(const u32x4*)(gap_ + 8);
                __syncthreads();
                if (!smp) {
                    float Pp = 1.f, Ss = 0.f;
#pragma unroll
                    for (int t = 0; t < 16; ++t) { const float a = Ab[(seg * 16 + t) * 128 + sch], b = Bb[(seg * 16 + t) * 128 + sch]; Ss = a * Ss + b; Pp *= a; }
                    SEGP[seg * 128 + sch] = Pp; SEGS[seg * 128 + sch] = Ss;
                    __syncthreads();
                    float cp = 1.f, hv = 0.f;
                    for (int s2 = 0; s2 < seg; ++s2) { const float pp = SEGP[s2 * 128 + sch], ss = SEGS[s2 * 128 + sch]; hv = pp * hv + ss; cp *= pp; }
#pragma unroll
                    for (int t = 0; t < 16; ++t) { const int o = (seg * 16 + t) * 128 + sch; const float a = Ab[o], b = Bb[o]; hv = a * hv + b; cp *= a; Ab[o] = hv; Bb[o] = cp; }
                    if (seg == 3) __hip_atomic_store(PS2 + (size_t)cc * D + schg, ((unsigned long long)__float_as_uint(hv) << 32) | __float_as_uint(cp), __ATOMIC_RELAXED, __HIP_MEMORY_SCOPE_AGENT);
                } else {
                    const int b = (cc - 128) * 4 + seg; float hv = p.in[4][b * D + schg];
#pragma unroll
                    for (int t = 0; t < 16; ++t) { const int o = (seg * 16 + t) * 128 + sch; const float a = Ab[o], bb = Bb[o]; hv = a * hv + bb; Ab[o] = hv; Bb[o] = 0.f; }
                    out[O_SRH + b * D + schg] = hv;
                    __syncthreads();
                }
                asm volatile("s_waitcnt vmcnt(0)" ::: "memory");
                __syncthreads();
                if (!smp) {
                    if (tid == 0) __hip_atomic_store(FLG + cc * 16 + h, 1u, __ATOMIC_RELAXED, __HIP_MEMORY_SCOPE_AGENT);
                    const int lo = cc < 16 ? 0 : cc - 16;
                    if (wid == 1) {
                        const int j = lo + lane;
                        if (j < cc) { unsigned spn = 0u; while (__hip_atomic_load(FLG + j * 16 + h, __ATOMIC_RELAXED, __HIP_MEMORY_SCOPE_AGENT) == 0u) { __builtin_amdgcn_s_sleep(1); if (++spn > (1u << 22)) break; } }
                    }
                    __syncthreads();
                    if (tid < 128) {
                        float pj[16], sj[16]; const int jmax = cc > 0 ? cc - 1 : 0;
#pragma unroll
                        for (int i = 0; i < 16; ++i) { const int jj = (lo + i) < jmax ? (lo + i) : jmax; const unsigned long long v = __hip_atomic_load(PS2 + (size_t)jj * D + h * 128 + tid, __ATOMIC_RELAXED, __HIP_MEMORY_SCOPE_AGENT); pj[i] = __uint_as_float((unsigned)v); sj[i] = __uint_as_float((unsigned)(v >> 32)); }
                        float cr = carry_run;
#pragma unroll
                        for (int i = 0; i < 16; ++i) cr = ((lo + i) < cc) ? pj[i] * cr + sj[i] : cr;
                        carry_run = cr; CARR[tid] = cr;
                        if (cc == 127) out[O_PRH + h * 128 + tid] = Ab[63 * 128 + tid] + Bb[63 * 128 + tid] * cr;
                    }
                } else { if (tid < 128) CARR[tid] = 0.f; }
                __syncthreads();
                {
                    const int row = tid >> 3, c16 = (tid & 7) * 16; const size_t o = (size_t)(r0 + row) * D + h * 128 + c16;
                    const LAS float* ha = Ab + row * 128 + c16; const LAS float* ca = Bb + row * 128 + c16; const LAS float* cr = CARR + c16;
                    float ov[16];
#pragma unroll
                    for (int q4 = 0; q4 < 4; ++q4) { const f32x4 hv4 = *(const LAS f32x4*)(ha + 4 * q4), cp4 = *(const LAS f32x4*)(ca + 4 * q4), cr4 = *(const LAS f32x4*)(cr + 4 * q4);
                        const unsigned g01 = q4 < 2 ? (q4 == 0 ? gq0.x : gq0.z) : (q4 == 2 ? gq1.x : gq1.z), g23 = q4 < 2 ? (q4 == 0 ? gq0.y : gq0.w) : (q4 == 2 ? gq1.y : gq1.w);
                        ov[4 * q4 + 0] = (hv4[0] + cp4[0] * cr4[0]) * gelu_tanh(bf_lo(g01)); ov[4 * q4 + 1] = (hv4[1] + cp4[1] * cr4[1]) * gelu_tanh(bf_hi(g01));
                        ov[4 * q4 + 2] = (hv4[2] + cp4[2] * cr4[2]) * gelu_tanh(bf_lo(g23)); ov[4 * q4 + 3] = (hv4[3] + cp4[3] * cr4[3]) * gelu_tanh(bf_hi(g23)); }
                    const u32x4 w0 = (u32x4){pk2h(ov[0], ov[1]), pk2h(ov[2], ov[3]), pk2h(ov[4], ov[5]), pk2h(ov[6], ov[7])}, w1 = (u32x4){pk2h(ov[8], ov[9]), pk2h(ov[10], ov[11]), pk2h(ov[12], ov[13]), pk2h(ov[14], ov[15])};
                    *(u32x4*)(HA + o) = w0; *(u32x4*)(HA + o + 8) = w1;
                }
            }
#undef ZR_ISSUE
        }
        if (c >= 32 && c < 64) {
            __syncthreads();
            pg8::MTSched S{c - 32, (const char*)KB, (const char*)WqN}; pg8::EpiBf16 E{MT, 8192}; pg8::gemm_phase(lds, S, E, 512, D, D, tid);
        }
        for (int w = c * 512 + tid; w < (MR / 16) * 256; w += G * 512) {
            const int rg = w >> 8, ch = (w & 255) * 4, r0 = rg * 16; const bool smp = r0 >= SEQ; const int b = (r0 - SEQ) >> 4;
            const f32x4 w0 = *(const f32x4*)(p.in[19] + ch), w1 = *(const f32x4*)(p.in[19] + DC + ch), w2 = *(const f32x4*)(p.in[19] + 2 * DC + ch);
            f32x4 m2, m1;
            if (smp) { m2 = *(const f32x4*)(p.in[5] + (size_t)b * 2 * DC + ch); m1 = *(const f32x4*)(p.in[5] + (size_t)b * 2 * DC + DC + ch); }
            else if (r0 == 0) { m2 = (f32x4){0.f, 0.f, 0.f, 0.f}; m1 = m2; }
            else { const bf16_t* z2 = Z + (size_t)(r0 - 2) * NIN + ch; const bf16_t* z1 = z2 + NIN;
                const u32x2 g2 = *(const u32x2*)(z2 + Z_GC), h2 = *(const u32x2*)(z2 + Z_HB), g1 = *(const u32x2*)(z1 + Z_GC), h1 = *(const u32x2*)(z1 + Z_HB);
                m2 = (f32x4){bf_lo(g2.x) * bf_lo(h2.x), bf_hi(g2.x) * bf_hi(h2.x), bf_lo(g2.y) * bf_lo(h2.y), bf_hi(g2.y) * bf_hi(h2.y)};
                m1 = (f32x4){bf_lo(g1.x) * bf_lo(h1.x), bf_hi(g1.x) * bf_hi(h1.x), bf_lo(g1.y) * bf_lo(h1.y), bf_hi(g1.y) * bf_hi(h1.y)}; }
#pragma unroll 8
            for (int t = 0; t < 16; ++t) { const bf16_t* z = Z + (size_t)(r0 + t) * NIN + ch;
                const u32x2 gc = *(const u32x2*)(z + Z_GC), hb = *(const u32x2*)(z + Z_HB), gb = *(const u32x2*)(z + Z_GB);
                const f32x4 cv = (f32x4){bf_lo(gc.x) * bf_lo(hb.x), bf_hi(gc.x) * bf_hi(hb.x), bf_lo(gc.y) * bf_lo(hb.y), bf_hi(gc.y) * bf_hi(hb.y)};
                const f32x4 gbf = (f32x4){bf_lo(gb.x), bf_hi(gb.x), bf_lo(gb.y), bf_hi(gb.y)};
                const f32x4 o = gbf * (w0 * m2 + w1 * m1 + w2 * cv);
                u32x2 ow; ow.x = pk2h(o[0], o[1]); ow.y = pk2h(o[2], o[3]); *(u32x2*)(HBb + (size_t)(r0 + t) * DC + ch) = ow;
                m2 = m1; m1 = cv; }
            if (smp) { float* o = out + O_SCB + (size_t)b * 2 * DC + ch; *(f32x4*)o = m2; *(f32x4*)(o + DC) = m1; }
            else if (r0 == SEQ - 16) { float* o = out + O_PCB + ch; *(f32x4*)o = m2; *(f32x4*)(o + DC) = m1; }
        }
        for (int e = c * 512 + tid; e < 9 * 3 * D; e += G * 512) { const int ch = e % D, k = (e / D) % 3, s = e / (3 * D);
            if (s == 0) out[O_PCA + k * D + ch] = bf1(Z[(size_t)(SEQ - 3 + k) * NIN + ch]);
            else out[O_SCA + (size_t)((s - 1) * 3 + k) * D + ch] = bf1(Z[(size_t)(SEQ + (s - 1) * 16 + 13 + k) * NIN + ch]); }
    }
    SEAM(2);
    if (IN(4)) { PHASE_VARS
        {
            const int r0 = SEQ + 32 * ((c >> 3) & 3), c0 = 32 * (8 * (c & 7) + (c >> 5));
            LAS float* red = (LAS float*)lds;
            const f32x16 accA = thin_mac_lds<1024>(lds, HA + (size_t)r0 * D, WpaT + (size_t)c0 * D, D, tid, wid, lane);
            const f32x16 accB = thin_mac_lds<1024>(lds, HBb + (size_t)r0 * DC, WpbT + (size_t)c0 * DC, DC, tid, wid, lane);
            __syncthreads();
            thin_put(red, accA, wid, lane);
            thin_put(red + 8192, accB, wid, lane);
            __syncthreads();
            float a0, a1, b0, b1; thin_get(red, tid, a0, a1); thin_get(red + 8192, tid, b0, b1);
            const int row = r0 + (tid >> 4), col = c0 + (tid & 15) * 2;
            const unsigned ga = *(const unsigned*)(Z + (size_t)row * NIN + Z_GATEA + col), gb = *(const unsigned*)(Z + (size_t)row * NIN + Z_GATEB + col);
            *(unsigned*)(MIX + (size_t)row * D + col) = pk2h(sigmoidf_(bf_lo(ga)) * a0 + sigmoidf_(bf_lo(gb)) * b0, sigmoidf_(bf_hi(ga)) * a1 + sigmoidf_(bf_hi(gb)) * b1);
            __syncthreads();
        }
#pragma unroll 1
        for (int pass_ = 0; pass_ < 2; ++pass_) {
            const bf16_t* A_ = pass_ ? HBb : HA; const bf16_t* B_ = pass_ ? WpbT : WpaT; const int K_ = pass_ ? DC : D;
            pg8::GridSched S; S.init(A_, B_, SEQ, D, K_, K_, G, c); pg8::EpiMix E{Z, MIX, pass_}; pg8::gemm_phase(lds, S, E, K_, K_, K_, tid);
        }
    }
    SEAM(4);
    if (IN(5)) { PHASE_VARS thin_gemm_bf16<1024>(lds, MIX, WoT, D, T, c, tid, wid, lane); pg8::GridSched S; S.init(MIX, WoT, SEQ, D, D, D, G, c); pg8::EpiBf16 E{T, D}; pg8::gemm_phase(lds, S, E, D, D, D, tid); }
    SEAM(5);
    if (IN(6)) { PHASE_VARS
        for (int m = gw; m < MR; m += NGW) { const float* xr = m < SEQ ? p.in[0] + (size_t)m * D : p.in[1] + (size_t)(m - SEQ) * D;
            if (m < SEQ) row_pass<true, 1, 1>(T + (size_t)m * D, xr, X1B + (size_t)m * D, p.in[10], p.in[23], nullptr, lane, RS1 + m);
            else row_pass<true, 1, 0>(T + (size_t)m * D, xr, X1B + (size_t)m * D, p.in[10], p.in[23], U2 + (size_t)m * D, lane); }
    }
    SEAM(6);
    if (IN(7)) { PHASE_VARS thin_gemm_bf16<1024>(lds, U2, WqT, D, Qb, c, tid, wid, lane); }
    SEAM(7);
    if (IN(8)) { PHASE_VARS
        if (c < 128) {
            pg8::AttnSSched S{G, c, (const char*)X1B, (const char*)MT}; pg8::EpiSoftmax E{Pb, 1024, 0.044194173824159216f * 1.4426950408889634f, RS1};
            pg8::gemm_phase(lds, S, E, D, D, 8192, tid);
        } else {
            if (c >= 192) {
                LAS float* scr = (LAS float*)(lds + wid * 16896);
                for (int it = (c - 192) * 8 + wid; it < 32 * 176; it += (G - 192) * 8) transpose_item(p.in[32], D, NUP, WupT, scr, it, lane);
            } else if (c >= 160) {
                pg8::NTSched S{c - 160, (const char*)WxoT, (const char*)VB}; pg8::EpiBf16 E{NT, 1024}; pg8::gemm_phase(lds, S, E, 512, D, D, tid);
            }
            for (int it = c - 128; it < 32; it += (G - 128)) {
                const int b = it >> 2, h = it & 3, R0 = SEQ + b * 16, fr = lane & 15, fq = lane >> 4;
                LAS float* Sc = (LAS float*)lds; LAS float* Pt = (LAS float*)(lds + 16384);
                __syncthreads();
                {
                    bf16x8 qf[16];
#pragma unroll
                    for (int s = 0; s < 16; ++s) qf[s] = *(const bf16x8*)(Qb + (size_t)(R0 + fr) * D + h * 512 + s * 32 + fq * 8);
#pragma unroll
                    for (int kb2 = 0; kb2 < 2; ++kb2) { const int key = (wid * 2 + kb2) * 16 + fr; f32x4 acc = (f32x4){0.f, 0.f, 0.f, 0.f};
                        const float* kp = p.in[7] + ((size_t)(b * 256 + key) * 4 + h) * 512 + fq * 8;
#pragma unroll
                        for (int s = 0; s < 16; ++s) { const f32x4 k0 = *(const f32x4*)(kp + s * 32), k1 = *(const f32x4*)(kp + s * 32 + 4);
                            u32x4 w; w.x = pk2h(k0[0], k0[1]); w.y = pk2h(k0[2], k0[3]); w.z = pk2h(k1[0], k1[1]); w.w = pk2h(k1[2], k1[3]);
                            acc = __builtin_amdgcn_mfma_f32_16x16x32_bf16(qf[s], __builtin_bit_cast(bf16x8, w), acc, 0, 0, 0); }
#pragma unroll
                        for (int e = 0; e < 4; ++e) Sc[(4 * fq + e) * 256 + key] = acc[e] * 0.044194173824159216f; }
                }
                __syncthreads();
#pragma unroll
                for (int qq = 0; qq < 2; ++qq) { const int q = wid * 2 + qq; float v[4]; float mx = -3.0e38f;
#pragma unroll
                    for (int i = 0; i < 4; ++i) { v[i] = Sc[q * 256 + lane + 64 * i]; mx = fmaxf(mx, v[i]); }
                    mx = wave_max(mx); float s = 0.f;
#pragma unroll
                    for (int i = 0; i < 4; ++i) { v[i] = __expf(v[i] - mx); s += v[i]; }
                    s = 1.0f / wave_sum(s);
#pragma unroll
                    for (int i = 0; i < 4; ++i) Pt[(lane + 64 * i) * 16 + q] = v[i] * s; }
                __syncthreads();
                {
                    float acc[16];
#pragma unroll
                    for (int q = 0; q < 16; ++q) acc[q] = 0.f;
                    const float* vp = p.in[8] + ((size_t)(b * 256) * 4 + h) * 512 + tid;
#pragma unroll 4
                    for (int m = 0; m < 256; ++m) { const float v = vp[(size_t)m * 2048];
#pragma unroll
                        for (int q4 = 0; q4 < 4; ++q4) { const f32x4 pr = *(const LAS f32x4*)(Pt + m * 16 + q4 * 4);
                            acc[q4 * 4 + 0] += pr[0] * v; acc[q4 * 4 + 1] += pr[1] * v; acc[q4 * 4 + 2] += pr[2] * v; acc[q4 * 4 + 3] += pr[3] * v; } }
#pragma unroll
                    for (int q = 0; q < 16; ++q) Ob[(size_t)(R0 + q) * D + h * 512 + tid] = (bf16_t)f2bf(acc[q]);
                }
            }
        }
    }
    SEAM(8);
    if (IN(10)) { PHASE_VARS thin_gemm_bf16<1024>(lds, Ob, WxoT, D, T2, c, tid, wid, lane); pg8::GridSched S; S.init(Pb, NT, SEQ, D, 1024, 1024, G, c); pg8::EpiBf16 E{T2, D}; pg8::gemm_phase(lds, S, E, 1024, 1024, 1024, tid); }
    SEAM(10);
    if (IN(11)) { PHASE_VARS
        LAS float* scr = (LAS float*)(lds + wid * 16896);
        constexpr int I_UP = 32 * 176, I_DN = 88 * 32;
        (void)scr; (void)I_UP;
        (void)I_DN;
        for (int m = gw; m < MR; m += NGW)
            row_pass<true, 3>(T2 + (size_t)m * D, X1B + (size_t)m * D, (bf16_t*)(out + (size_t)m * D) + D, p.in[24], p.in[30], U3 + (size_t)m * D, lane);
    }
    SEAM(11);
    if (IN(12)) { PHASE_VARS pg8::GridSched S; S.init(U3, WupT, MP, NUP, D, D, G, c); pg8::EpiBf16 E{UP, NUP}; pg8::gemm_phase(lds, S, E, D, D, D, tid);
        if (c >= 172) {
            __syncthreads();
            LAS float* scr = (LAS float*)(lds + wid * 16896);
            for (int it = (c - 172) * 8 + wid; it < 88 * 32; it += (G - 172) * 8) transpose_item(p.in[35], DFF, D, WdnT, scr, it, lane);
        } }
    SEAM(12);
    if (IN(13)) { PHASE_VARS
        constexpr int NCG = DFF / 8;
        const float* cwp = p.in[33]; const float* cbp = p.in[34];
        for (int w = c * 512 + tid; w < (MR / 16) * NCG; w += G * 512) {
            const int rg = w / NCG, cg = w - rg * NCG, r0 = rg * 16, ch = cg * 8; const bool smp = r0 >= SEQ; const int b = (r0 - SEQ) >> 4;
            float wg[3][8], wv[3][8], bg[8], bv[8], g2[8], g1[8], v2[8], v1[8];
#pragma unroll
            for (int k = 0; k < 3; ++k) { const f32x4 a0 = *(const f32x4*)(cwp + k * NUP + ch), a1 = *(const f32x4*)(cwp + k * NUP + ch + 4), c0 = *(const f32x4*)(cwp + k * NUP + DFF + ch), c1 = *(const f32x4*)(cwp + k * NUP + DFF + ch + 4);
#pragma unroll
                for (int e = 0; e < 4; ++e) { wg[k][e] = a0[e]; wg[k][4 + e] = a1[e]; wv[k][e] = c0[e]; wv[k][4 + e] = c1[e]; } }
            { const f32x4 a0 = *(const f32x4*)(cbp + ch), a1 = *(const f32x4*)(cbp + ch + 4), c0 = *(const f32x4*)(cbp + DFF + ch), c1 = *(const f32x4*)(cbp + DFF + ch + 4);
#pragma unroll
                for (int e = 0; e < 4; ++e) { bg[e] = a0[e]; bg[4 + e] = a1[e]; bv[e] = c0[e]; bv[4 + e] = c1[e]; } }
            if (smp) { const float* s0 = p.in[6] + (size_t)b * 2 * NUP + ch;
#pragma unroll
                for (int e = 0; e < 8; ++e) { g2[e] = s0[e]; v2[e] = s0[DFF + e]; g1[e] = s0[NUP + e]; v1[e] = s0[NUP + DFF + e]; } }
            else if (r0 == 0) {
#pragma unroll
                for (int e = 0; e < 8; ++e) { g2[e] = 0.f; g1[e] = 0.f; v2[e] = 0.f; v1[e] = 0.f; } }
            else { const bf16_t* u2 = UP + (size_t)(r0 - 2) * NUP + ch; const u32x4 a2 = *(const u32x4*)u2, c2 = *(const u32x4*)(u2 + DFF), a1 = *(const u32x4*)(u2 + NUP), c1 = *(const u32x4*)(u2 + NUP + DFF);
#pragma unroll
                for (int e = 0; e < 4; ++e) { g2[2 * e] = bf_lo(a2[e]); g2[2 * e + 1] = bf_hi(a2[e]); v2[2 * e] = bf_lo(c2[e]); v2[2 * e + 1] = bf_hi(c2[e]);
                    g1[2 * e] = bf_lo(a1[e]); g1[2 * e + 1] = bf_hi(a1[e]); v1[2 * e] = bf_lo(c1[e]); v1[2 * e + 1] = bf_hi(c1[e]); } }
#pragma unroll 2
            for (int t = 0; t < 16; ++t) { const bf16_t* u = UP + (size_t)(r0 + t) * NUP + ch; const u32x4 ua = *(const u32x4*)u, uc = *(const u32x4*)(u + DFF);
                float ga[8], va[8], o[8];
#pragma unroll
                for (int e = 0; e < 4; ++e) { ga[2 * e] = bf_lo(ua[e]); ga[2 * e + 1] = bf_hi(ua[e]); va[2 * e] = bf_lo(uc[e]); va[2 * e + 1] = bf_hi(uc[e]); }
#pragma unroll
                for (int e = 0; e < 8; ++e) { const float yg = bg[e] + wg[0][e] * g2[e] + wg[1][e] * g1[e] + wg[2][e] * ga[e], yv = bv[e] + wv[0][e] * v2[e] + wv[1][e] * v1[e] + wv[2][e] * va[e];
                    o[e] = gelu_tanh(yg) * yv; g2[e] = g1[e]; g1[e] = ga[e]; v2[e] = v1[e]; v1[e] = va[e]; }
                u32x4 ow; ow.x = pk2h(o[0], o[1]); ow.y = pk2h(o[2], o[3]); ow.z = pk2h(o[4], o[5]); ow.w = pk2h(o[6], o[7]);
                *(u32x4*)(Gb + (size_t)(r0 + t) * DFF + ch) = ow; }
            if (smp || r0 == SEQ - 16) { float* o = (smp ? out + O_SCF + (size_t)b * 2 * NUP : out + O_PCF) + ch;
#pragma unroll
                for (int e = 0; e < 8; ++e) { o[e] = g2[e]; o[DFF + e] = v2[e]; o[NUP + e] = g1[e]; o[NUP + DFF + e] = v1[e]; } }
        }
    }
    SEAM(13);
    if (IN(14)) { PHASE_VARS thin_gemm_bf16<512>(lds, Gb, WdnT, DFF, T, c, tid, wid, lane); pg8::GridSched S; S.init(Gb, WdnT, SEQ, D, DFF, DFF, G, c); pg8::EpiBf16 E{T, D}; pg8::gemm_phase(lds, S, E, DFF, DFF, DFF, tid); }
    SEAM(14);
    if (IN(15)) { PHASE_VARS
        for (int m = gw; m < MR; m += NGW)
            final_row_pass(T + (size_t)m * D, out + (size_t)m * D, p.in[31], lane);
    }
    if (p.ph_lo < 0) grid.sync();
#undef IN
#undef SEAM
#undef out
#undef WSP
#undef WinT
#undef WkvT
#undef WpaT
#undef WpbT
#undef WoT
#undef WqT
#undef WxoT
#undef WrT
#undef WiT
#undef WupT
#undef WdnT
#undef KB
#undef VB
#undef NT
#undef WqN
#undef MT
#undef RS1
#undef MN
#undef PSP
#undef PSS
#undef FLG
#undef PS2
#undef Z
#undef UP
#undef X1B
#undef T
#undef U
#undef HLOC
#undef MIX
#undef Qb
#undef CP
#undef U2
#undef Ob
#undef HA
#undef Pb
#undef HBb
#undef U3
#undef T2
#undef Gb
#undef PHASE_VARS
}
constexpr int NPH = 16;

extern "C" void kernel_launch(void* const* d_in, const int* in_sizes, int n_in, void* d_out, int out_size, void* d_ws, size_t ws_size, hipStream_t stream) {
    static int grid = 0;
    if (grid == 0) {
        if (n_in != 36 || out_size != 18382848 || ws_size < WS_END + 16777216 + 65536) { fprintf(stderr, "kernel_launch: unexpected shapes: n_in %d out %d ws %zu (need %zu)\n", n_in, out_size, ws_size, (size_t)WS_END); grid = -1; return; }
        int dev = 0, cus = 0, per_cu = 0;
        hipGetDevice(&dev); hipDeviceGetAttribute(&cus, hipDeviceAttributeMultiprocessorCount, dev);
        if (hipFuncSetAttribute((const void*)mega, hipFuncAttributeMaxDynamicSharedMemorySize, LDS_BYTES) != hipSuccess) { fprintf(stderr, "kernel_launch: hipFuncSetAttribute failed\n"); grid = -1; return; }
        hipOccupancyMaxActiveBlocksPerMultiprocessor(&per_cu, (const void*)mega, 512, LDS_BYTES);
        if (per_cu < 1 || cus * per_cu < 256) { fprintf(stderr, "kernel_launch: occupancy %d x %d CUs < 256 workgroups\n", per_cu, cus); grid = -1; return; }
        grid = 256;
    }
    if (grid < 0) return;
    hipMemsetAsync((char*)d_ws + WS_BAR, 0, 32768, stream);
    Params p{};
    for (int i = 0; i < 36; ++i) p.in[i] = (const float*)d_in[i];
    p.out = (float*)d_out; p.ws = (unsigned char*)d_ws;
#if PROBE_PH >= 0
    { const int cuts[4] = {0, PROBE_PH + 1, PROBE_PH, NPH}; const int ends[3] = {PROBE_PH + 1, PROBE_PH + 1, NPH};
      for (int k = 0; k < 3; ++k) { p.ph_lo = (k == 0) ? 0 : (k == 1 ? PROBE_PH : PROBE_PH + 1); p.ph_hi = ends[k]; (void)cuts; void* args[] = {&p};
        if (k > 0) (void)hipMemsetAsync((char*)d_ws + WS_BAR, 0, 32768, stream);
        hipError_t e = hipLaunchCooperativeKernel((const void*)mega, dim3(grid), dim3(512), args, LDS_BYTES, stream);
        if (e != hipSuccess) { fprintf(stderr, "launch %d failed: %s\n", k, hipGetErrorString(e)); break; } } }
#elif N_LAUNCH_MODE == 1
    p.ph_lo = 0; p.ph_hi = NPH;
    { void* args[] = {&p}; hipError_t e = hipLaunchCooperativeKernel((const void*)mega, dim3(grid), dim3(512), args, LDS_BYTES, stream);
      if (e != hipSuccess) fprintf(stderr, "cooperative launch failed: %s\n", hipGetErrorString(e)); }
#else
    for (int k = 0; k < NPH; ++k) { p.ph_lo = k; p.ph_hi = k + 1; void* args[] = {&p};
        hipError_t e = hipLaunchCooperativeKernel((const void*)mega, dim3(grid), dim3(512), args, LDS_BYTES, stream);
        if (e != hipSuccess) { fprintf(stderr, "launch %d failed: %s\n", k, hipGetErrorString(e)); break; } }
#endif
}
```

```cpp
#include <hip/hip_runtime.h>
#include <hip/hip_cooperative_groups.h>
#include <cstdio>
#include <cstdint>
namespace cg = cooperative_groups;

#ifndef N_LAUNCH_MODE
#define N_LAUNCH_MODE 1
#endif
#ifndef PROBE_PH
#define PROBE_PH -1
#endif
#ifndef USE_XCD_BAR
#define USE_XCD_BAR 1
#endif

#define LAS __attribute__((address_space(3)))
typedef unsigned short bf16_t;
typedef short bf16x8 __attribute__((ext_vector_type(8)));
typedef float f32x4 __attribute__((ext_vector_type(4)));
typedef float f32x16 __attribute__((ext_vector_type(16)));
typedef unsigned u32x4 __attribute__((ext_vector_type(4)));
typedef unsigned u32x2 __attribute__((ext_vector_type(2)));

constexpr int D = 2048, SEQ = 8192, MR = 8320, MP = 8448, NIN = 11264, DC = 1024, DFF = 5632, NUP = 11264, NMEM = 256;
constexpr int Z_GA = 2048, Z_GB = 4096, Z_GC = 5120, Z_HB = 6144, Z_GATEA = 7168, Z_GATEB = 9216;
constexpr int NCHUNK = 130;
constexpr float EPS = 1e-6f;
constexpr size_t O_YP = 0, O_PCA = 17039360, O_PRH = 17045504, O_PCB = 17047552, O_PCF = 17049600, O_PMK = 17072128, O_PMV = 17596416,
                 O_SCA = 18120704, O_SRH = 18169856, O_SCB = 18186240, O_SCF = 18202624;
constexpr size_t WS_WKV = 0, WS_WPA = 16777216, WS_WPB = 25165824, WS_WO = 29360128, WS_WQ = 37748736, WS_WXO = 46137344,
                 WS_WR = 54525952, WS_WI = 55050240, WS_KB = 55574528, WS_VT = 56623104, WS_MN = 57671680, WS_PSP = 58720256, WS_PSS = 59785216,
                 WS_BAR = 60850176, WS_Z = 60915712, WS_T = WS_Z + 190316544, WS_B = WS_T + 46137344, WS_END = WS_B + 121110528;
constexpr size_t B1 = WS_B, B2 = WS_B + 34603008, B3 = WS_B + 69206016, B4 = WS_B + 103809024;
constexpr size_t WS_WIN = WS_T, WS_WUP = WS_B, WS_U3 = WS_B + 46137344, WS_G = WS_B, WS_WDN = WS_B + 95158272;
constexpr int LDS_BYTES = 153600;

struct Params { const float* in[36]; float* out; unsigned char* ws; int ph_lo, ph_hi; };

__device__ __forceinline__ unsigned f2bf(float f) { unsigned u = __float_as_uint(f); return (u + 0x7fffu + ((u >> 16) & 1u)) >> 16; }
__device__ __forceinline__ unsigned pk2(float lo, float hi) { return f2bf(lo) | (f2bf(hi) << 16); }
__device__ __forceinline__ unsigned pk2h(float lo, float hi) { unsigned r; asm("v_cvt_pk_bf16_f32 %0, %1, %2" : "=v"(r) : "v"(lo), "v"(hi)); return r; }
__device__ __forceinline__ float bf_lo(unsigned u) { return __uint_as_float(u << 16); }
__device__ __forceinline__ float bf_hi(unsigned u) { return __uint_as_float(u & 0xffff0000u); }
__device__ __forceinline__ float bf1(bf16_t b) { return __uint_as_float(((unsigned)b) << 16); }
__device__ __forceinline__ float wave_sum(float v) {
#pragma unroll
    for (int o = 1; o < 64; o <<= 1) v += __shfl_xor(v, o);
    return v;
}
__device__ __forceinline__ float wave_max(float v) {
#pragma unroll
    for (int o = 1; o < 64; o <<= 1) v = fmaxf(v, __shfl_xor(v, o));
    return v;
}
__device__ __forceinline__ float sigmoidf_(float x) { return __builtin_amdgcn_rcpf(1.0f + __expf(-x)); }
__device__ __forceinline__ float gelu_tanh(float x) { const float u = 1.5957691216057308f * (x + 0.044715f * x * x * x); return x * __builtin_amdgcn_rcpf(1.0f + __expf(-u)); }
#define LDS_WAIT() asm volatile("s_waitcnt lgkmcnt(0)" ::: "memory")
__device__ __forceinline__ int lane_id_() { int l; asm volatile("v_mbcnt_lo_u32_b32 %0, -1, 0\n\tv_mbcnt_hi_u32_b32 %0, -1, %0" : "=v"(l)); return l; }

#define XB_TMO      128
#define XB_XCNT(j)  (256  + 64 * (j))
#define XB_XSUB(j)  (1280 + 64 * (j))
#define XB_XGEN(j)  (2304 + 64 * (j))
#define XB_TOP      3328
#define XB_TOPGEN   3392
#define XCD_BAR_WORDS 3456
#define XB_SPIN_CAP (1u << 22)
__device__ __forceinline__ unsigned xb_ld(unsigned* p)              { return __hip_atomic_load(p, __ATOMIC_RELAXED, __HIP_MEMORY_SCOPE_AGENT); }
__device__ __forceinline__ unsigned xb_add(unsigned* p, unsigned v) { return __hip_atomic_fetch_add(p, v, __ATOMIC_RELAXED, __HIP_MEMORY_SCOPE_AGENT); }
__device__ __forceinline__ unsigned xb_xcc_id() { return (unsigned)__builtin_amdgcn_s_getreg((3 << 11) | 20) & 0xFu; }
#define XB_SPIN(cond, bar) do { unsigned _sp = 0; while (cond) { __builtin_amdgcn_s_sleep(1); \
    if ((++_sp & 255u) == 0u) { if (xb_ld(&(bar)[XB_TMO])) break; if (_sp > XB_SPIN_CAP) { atomicAdd(&(bar)[XB_TMO], 1u); break; } } } } while (0)
struct XcdBarrier { unsigned* bar; unsigned x; volatile LAS unsigned* st; };
__device__ __forceinline__ XcdBarrier xcd_barrier_post(unsigned* bar, volatile LAS unsigned* st) {
    XcdBarrier b; b.bar = bar; b.x = xb_xcc_id(); b.st = st;
    if (threadIdx.x == 0) (void)xb_add(&bar[XB_XCNT(b.x)], 1u);
    return b;
}
__device__ __forceinline__ void xcd_barrier_complete(unsigned* bar, unsigned x, unsigned& nloc, unsigned& nx) {
    const unsigned G = gridDim.x * gridDim.y * gridDim.z;
    unsigned sum, cnt, mine, sp = 0u;
    for (;;) {
        sum = 0u; cnt = 0u; mine = 0u;
#pragma unroll
        for (unsigned j = 0; j < 16; ++j) { const unsigned c = xb_ld(&bar[XB_XCNT(j)]); sum += c; cnt += (c > 0u) ? 1u : 0u; mine = (j == x) ? c : mine; }
        if (sum == G) break;
        __builtin_amdgcn_s_sleep(1);
        if ((++sp & 255u) == 0u) { if (xb_ld(&bar[XB_TMO])) break; if (sp > XB_SPIN_CAP) { atomicAdd(&bar[XB_TMO], 1u); break; } }
    }
    nloc = mine > 0u ? mine : 1u; nx = cnt > 0u ? cnt : 1u;
}
__device__ __forceinline__ void xcd_barrier(const XcdBarrier& b, const bool leader) {
    asm volatile("s_waitcnt vmcnt(0)" ::: "memory");
    __syncthreads();
    if (leader) {
        unsigned* bar = b.bar;
        __builtin_amdgcn_s_waitcnt(0);
        unsigned nloc = b.st[0], nx = b.st[1];
        if (nloc == 0u) { xcd_barrier_complete(bar, b.x, nloc, nx); b.st[0] = nloc; b.st[1] = nx; }
        const unsigned old = xb_add(&bar[XB_XSUB(b.x)], 1u);
        const unsigned gen = old / nloc;
        if (old + 1u == (gen + 1u) * nloc) {
            __builtin_amdgcn_fence(__ATOMIC_RELEASE, "agent");
            asm volatile("s_waitcnt vmcnt(0)" ::: "memory");
            const unsigned og = xb_add(&bar[XB_TOP], 1u);
            const unsigned tg = og / nx;
            if (og + 1u == (tg + 1u) * nx) xb_add(&bar[XB_TOPGEN], 1u);
            else XB_SPIN(xb_ld(&bar[XB_TOPGEN]) == tg, bar);
            __builtin_amdgcn_fence(__ATOMIC_ACQUIRE, "agent");
            xb_add(&bar[XB_XGEN(b.x)], 1u);
            asm volatile("s_waitcnt vmcnt(0)" ::: "memory");
        } else {
            XB_SPIN(xb_ld(&bar[XB_XGEN(b.x)]) == gen, bar);
            __builtin_amdgcn_fence(__ATOMIC_ACQUIRE, "agent");
            asm volatile("s_waitcnt vmcnt(0)" ::: "memory");
        }
    }
    __syncthreads();
}

namespace pg8 {
constexpr int BM = 256, BK = 64, HALF = 128, HTB = HALF * BK * 2, STAGE_BYTES = 8 * HTB, NXCD = 8, WGM = 8;
__host__ __device__ __forceinline__ int lds_byte(int r, int c) { const int st = (r >> 4) * 2 + (c >> 5), rr = r & 15, cc = c & 31, ob = rr * 64 + cc * 2; return st * 1024 + (ob ^ (((ob >> 9) & 1) << 5)); }
__host__ __device__ __forceinline__ void stage_rc(int b, int& R, int& C) { const int st = b / 1024, sb = b % 1024, swz = sb ^ (((sb >> 9) & 1) << 5); R = (st >> 1) * 16 + swz / 64; C = (st & 1) * 32 + (swz % 64) / 2; }
__host__ __device__ __forceinline__ int perm32(int rho) { const int n = rho >> 4, i = rho & 15; return 8 * (i >> 2) + 4 * n + (i & 3); }

struct Unit { int pm, pn, h, col0; };

struct GridSched {
    int nM, nN, nwg, G, c; const char* A; const char* Bt; size_t atile, btile;
    __device__ __forceinline__ void init(const void* A_, const void* Bt_, int M, int N, int lda, int ldb, int G_, int c_) {
        nM = M / BM; nN = N / BM; nwg = nM * nN; G = G_; c = c_; A = (const char*)A_; Bt = (const char*)Bt_; atile = (size_t)BM * lda * 2; btile = (size_t)BM * ldb * 2; }
    __device__ __forceinline__ bool next(int i, Unit& u) const {
        const long L = (long)i * G + c; if (L >= nwg) return false;
        int wgid = (int)L; { const int q = nwg / NXCD, r = nwg % NXCD, xcd = wgid % NXCD, off = wgid / NXCD; wgid = (xcd < r ? xcd * (q + 1) : r * (q + 1) + (xcd - r) * q) + off; }
        const int nig = WGM * nN, gid = wgid / nig, fm = gid * WGM, gsz = (nM - fm) < WGM ? (nM - fm) : WGM;
        u.pm = fm + ((wgid % nig) % gsz); u.pn = (wgid % nig) / gsz; u.h = 0; u.col0 = u.pn * BM; return true;
    }
    __device__ __forceinline__ const char* abase(const Unit& u) const { return A + (size_t)u.pm * atile; }
    __device__ __forceinline__ const char* bbase(const Unit& u) const { return Bt + (size_t)u.pn * btile; }
};
struct AttnSSched {
    int G, c; const char* Q; const char* KB;
    __device__ __forceinline__ bool next(int i, Unit& u) const { const int L = i * G + c; if (L >= 128) return false; const int x = L & 7, j = L >> 3; u.pm = 4 * x + (j >> 2); u.h = j & 3; u.pn = 0; u.col0 = u.h * 256; return true; }
    __device__ __forceinline__ const char* abase(const Unit& u) const { return Q + (size_t)u.pm * 256 * 2048 * 2; }
    __device__ __forceinline__ const char* bbase(const Unit& u) const { return KB + (size_t)u.h * 2048 * 2; }
};
struct MTSched {
    int L; const char* KB_; const char* WqN_;
    __device__ __forceinline__ bool next(int i, Unit& u) const { if (i > 0) return false; u.pm = 0; u.h = L >> 3; u.pn = L & 7; u.col0 = u.h * 2048 + u.pn * 256; return true; }
    __device__ __forceinline__ const char* abase(const Unit& u) const { return KB_ + (size_t)u.h * 512 * 2; }
    __device__ __forceinline__ const char* bbase(const Unit& u) const { return WqN_ + ((size_t)u.pn * 256 * 2048 + u.h * 512) * 2; }
};
struct NTSched {
    int L; const char* WxoT_; const char* VB_;
    __device__ __forceinline__ bool next(int i, Unit& u) const { if (i > 0) return false; u.pm = L & 7; u.h = L >> 3; u.pn = 0; u.col0 = u.h * 256; return true; }
    __device__ __forceinline__ const char* abase(const Unit& u) const { return WxoT_ + ((size_t)u.pm * 256 * 2048 + u.h * 512) * 2; }
    __device__ __forceinline__ const char* bbase(const Unit& u) const { return VB_ + (size_t)u.h * 512 * 2; }
};

struct EpiBf16 {
    static constexpr bool PERM = true, AFTER_DRAIN = false;
    bf16_t* O; int ldc;
    __device__ __forceinline__ void operator()(const f32x4 (&acc)[2][2][4][2], const Unit& u, int wr, int wc, int fr, int fq) const {
        const int row0 = u.pm * BM + wr * 64 + fr; const int col0 = u.col0 + wc * 32 + 8 * fq;
#pragma unroll
        for (int ai = 0; ai < 2; ++ai)
#pragma unroll
            for (int m = 0; m < 4; ++m) { bf16_t* rowp = O + (size_t)(row0 + ai * HALF + m * 16) * ldc + col0;
#pragma unroll
                for (int bj = 0; bj < 2; ++bj) { const f32x4 v0 = acc[ai][bj][m][0], v1 = acc[ai][bj][m][1];
                    u32x4 w; w.x = pk2(v0[0], v0[1]); w.y = pk2(v0[2], v0[3]); w.z = pk2(v1[0], v1[1]); w.w = pk2(v1[2], v1[3]);
                    *(u32x4*)(rowp + bj * HALF) = w; } }
    }
};
struct EpiKV {
    static constexpr bool PERM = false, AFTER_DRAIN = false;
    float* outk; float* outv; bf16_t* KB; bf16_t* VB;
    __device__ __forceinline__ void operator()(const f32x4 (&acc)[2][2][4][2], const Unit& u, int wr, int wc, int fr, int fq) const {
        const int row0 = u.pm * BM + wr * 64 + fr; const bool isk = u.pn < 8; const int col0 = (isk ? u.col0 : u.col0 - 2048) + wc * 32 + 4 * fq;
        float* ob = isk ? outk : outv;
#pragma unroll
        for (int ai = 0; ai < 2; ++ai)
#pragma unroll
            for (int m = 0; m < 4; ++m) { const size_t ro = (size_t)(row0 + ai * HALF + m * 16) * 2048 + col0;
#pragma unroll
                for (int bj = 0; bj < 2; ++bj)
#pragma unroll
                    for (int n = 0; n < 2; ++n) { const f32x4 v = acc[ai][bj][m][n]; *(f32x4*)(ob + ro + bj * HALF + n * 16) = v;
                        { u32x2 w; w.x = pk2(v[0], v[1]); w.y = pk2(v[2], v[3]); *(u32x2*)((isk ? KB : VB) + ro + bj * HALF + n * 16) = w; } } }
    }
};
struct EpiMix {
    static constexpr bool PERM = true, AFTER_DRAIN = false;
    const bf16_t* Z; bf16_t* MIX; int SECOND;
    __device__ __forceinline__ void operator()(const f32x4 (&acc)[2][2][4][2], const Unit& u, int wr, int wc, int fr, int fq) const {
        const int row0 = u.pm * BM + wr * 64 + fr; const int col0 = u.col0 + wc * 32 + 8 * fq;
#pragma unroll
        for (int ai = 0; ai < 2; ++ai) {
            u32x4 g[4][2], o[4][2];
#pragma unroll
            for (int m = 0; m < 4; ++m)
#pragma unroll
                for (int bj = 0; bj < 2; ++bj) { const int row = row0 + ai * HALF + m * 16;
                    g[m][bj] = *(const u32x4*)(Z + (size_t)row * NIN + (SECOND ? Z_GATEB : Z_GATEA) + col0 + bj * HALF);
                    if (SECOND) o[m][bj] = *(const u32x4*)(MIX + (size_t)row * D + col0 + bj * HALF); }
#pragma unroll
            for (int m = 0; m < 4; ++m)
#pragma unroll
                for (int bj = 0; bj < 2; ++bj) { const int row = row0 + ai * HALF + m * 16; const f32x4 a0 = acc[ai][bj][m][0], a1 = acc[ai][bj][m][1]; const u32x4 gg = g[m][bj];
                    float v[8];
                    v[0] = sigmoidf_(bf_lo(gg.x)) * a0[0]; v[1] = sigmoidf_(bf_hi(gg.x)) * a0[1]; v[2] = sigmoidf_(bf_lo(gg.y)) * a0[2]; v[3] = sigmoidf_(bf_hi(gg.y)) * a0[3];
                    v[4] = sigmoidf_(bf_lo(gg.z)) * a1[0]; v[5] = sigmoidf_(bf_hi(gg.z)) * a1[1]; v[6] = sigmoidf_(bf_lo(gg.w)) * a1[2]; v[7] = sigmoidf_(bf_hi(gg.w)) * a1[3];
                    if (SECOND) { const u32x4 oo = o[m][bj]; v[0] += bf_lo(oo.x); v[1] += bf_hi(oo.x); v[2] += bf_lo(oo.y); v[3] += bf_hi(oo.y); v[4] += bf_lo(oo.z); v[5] += bf_hi(oo.z); v[6] += bf_lo(oo.w); v[7] += bf_hi(oo.w); }
                    u32x4 w; w.x = pk2(v[0], v[1]); w.y = pk2(v[2], v[3]); w.z = pk2(v[4], v[5]); w.w = pk2(v[6], v[7]);
                    *(u32x4*)(MIX + (size_t)row * D + col0 + bj * HALF) = w; }
        }
    }
};
struct EpiSoftmax {
    static constexpr bool PERM = false, AFTER_DRAIN = true;
    bf16_t* P; int ldc; float sc; const float* rs;
    __device__ __forceinline__ void fused(f32x4 (&acc)[2][2][4][2], const Unit& u, int wr, int wc, int fr, int fq, LAS unsigned char* lds, int wid, int lane) const {
        LAS float* TM = (LAS float*)lds; LAS float* TS = (LAS float*)(lds + 4096);
#pragma unroll
        for (int ai = 0; ai < 2; ++ai)
#pragma unroll
            for (int m = 0; m < 4; ++m) { float mx = -3.0e38f; const float scr_ = sc * rs[u.pm * BM + ai * HALF + wr * 64 + m * 16 + fr];
#pragma unroll
                for (int bj = 0; bj < 2; ++bj)
#pragma unroll
                    for (int n = 0; n < 2; ++n) { f32x4 v = acc[ai][bj][m][n] * scr_; acc[ai][bj][m][n] = v; mx = fmaxf(mx, fmaxf(fmaxf(v[0], v[1]), fmaxf(v[2], v[3]))); }
                mx = fmaxf(mx, __shfl_xor(mx, 16)); mx = fmaxf(mx, __shfl_xor(mx, 32));
                if (fq == 0) TM[(ai * HALF + wr * 64 + m * 16 + fr) * 4 + wc] = mx; }
        LDS_WAIT(); __builtin_amdgcn_s_barrier(); asm volatile("" ::: "memory");
#pragma unroll
        for (int ai = 0; ai < 2; ++ai)
#pragma unroll
            for (int m = 0; m < 4; ++m) { const int r = ai * HALF + wr * 64 + m * 16 + fr; const f32x4 t = *(const LAS f32x4*)(TM + r * 4);
                const float mx = fmaxf(fmaxf(t[0], t[1]), fmaxf(t[2], t[3])); float s = 0.f;
#pragma unroll
                for (int bj = 0; bj < 2; ++bj)
#pragma unroll
                    for (int n = 0; n < 2; ++n) { f32x4 v = acc[ai][bj][m][n];
                        v[0] = __builtin_amdgcn_exp2f(v[0] - mx); v[1] = __builtin_amdgcn_exp2f(v[1] - mx); v[2] = __builtin_amdgcn_exp2f(v[2] - mx); v[3] = __builtin_amdgcn_exp2f(v[3] - mx);
                        acc[ai][bj][m][n] = v; s += (v[0] + v[1]) + (v[2] + v[3]); }
                s += __shfl_xor(s, 16); s += __shfl_xor(s, 32);
                if (fq == 0) TS[r * 4 + wc] = s; }
        LDS_WAIT(); __builtin_amdgcn_s_barrier(); asm volatile("" ::: "memory");
#pragma unroll
        for (int ai = 0; ai < 2; ++ai)
#pragma unroll
            for (int m = 0; m < 4; ++m) { const int r = ai * HALF + wr * 64 + m * 16 + fr; const f32x4 t = *(const LAS f32x4*)(TS + r * 4);
                const float inv = 1.0f / ((t[0] + t[1]) + (t[2] + t[3]));
                bf16_t* rowp = P + (size_t)(u.pm * BM + r) * ldc + u.col0 + wc * 32 + 4 * fq;
#pragma unroll
                for (int bj = 0; bj < 2; ++bj)
#pragma unroll
                    for (int n = 0; n < 2; ++n) { const f32x4 v = acc[ai][bj][m][n] * inv; u32x2 w; w.x = pk2(v[0], v[1]); w.y = pk2(v[2], v[3]); *(u32x2*)(rowp + bj * HALF + n * 16) = w; } }
    }
};

template <class Epi, class Sched>
__device__ __forceinline__ void gemm_phase(LAS unsigned char* lds, const Sched& S, const Epi& E, const int K, const int lda, const int ldb, const int tid) {
    constexpr bool ALIGN_EPI = !Epi::AFTER_DRAIN;
    const int wid = __builtin_amdgcn_readfirstlane(tid >> 6), lane = tid & 63, wr = wid >> 2, wc = wid & 3, fr = lane & 15, fq = lane >> 4;
    const int nt = K / BK;
    unsigned voffA[2], voffB[2];
#pragma unroll
    for (int i = 0; i < 2; ++i) { int R, C; stage_rc(tid * 16 + i * 8192, R, C); const int Rb = Epi::PERM ? ((R & ~31) + perm32(R & 31)) : R;
        voffA[i] = (unsigned)(R * lda + C) * 2u; voffB[i] = (unsigned)(Rb * ldb + C) * 2u; }
    const size_t kstep = (size_t)(BK * 2);
    const size_t hstepA = (size_t)HALF * lda * 2, hstepB = (size_t)HALF * ldb * 2;
    const unsigned ldsw = (unsigned)wid * 1024u;
    const int aoff = lds_byte(wr * 64 + fr, fq * 8), boff = lds_byte(wc * 32 + fr, fq * 8);
#define PG8_SA(b, h) (((b) * 2 + (h)) * HTB)
#define PG8_SB(b, h) ((4 + (b) * 2 + (h)) * HTB)
#define PG8_STAGE(bufoff, gbase, voff) do { _Pragma("unroll") for (int _i = 0; _i < 2; ++_i) \
        __builtin_amdgcn_global_load_lds((const unsigned*)((const char*)(gbase) + (voff)[_i]), (LAS unsigned*)(lds + (bufoff) + ldsw + _i * 8192), 16, 0, 0); } while (0)
#define PG8_LDA(dst, b, h) do { _Pragma("unroll") for (int m = 0; m < 4; ++m) _Pragma("unroll") for (int k = 0; k < 2; ++k) dst[m][k] = *(const LAS bf16x8*)(lds + PG8_SA(b, h) + aoff + m * 2048 + k * 1024); } while (0)
#define PG8_LDB(dst, b, h) do { _Pragma("unroll") for (int n = 0; n < 2; ++n) _Pragma("unroll") for (int k = 0; k < 2; ++k) dst[n][k] = *(const LAS bf16x8*)(lds + PG8_SB(b, h) + boff + n * 2048 + k * 1024); } while (0)
#define PG8_MMA(ai, bj, At, Bt) do { __builtin_amdgcn_s_setprio(1); _Pragma("unroll") for (int m = 0; m < 4; ++m) _Pragma("unroll") for (int n = 0; n < 2; ++n) _Pragma("unroll") for (int k = 0; k < 2; ++k) \
        acc[ai][bj][m][n] = __builtin_amdgcn_mfma_f32_16x16x32_bf16(Bt[n][k], At[m][k], acc[ai][bj][m][n], 0, 0, 0); __builtin_amdgcn_s_setprio(0); } while (0)
#define PG8_WAIT_V(n) asm volatile("s_waitcnt vmcnt(" #n ")" ::: "memory")
#define PG8_WAIT_L(n) asm volatile("s_waitcnt lgkmcnt(" #n ")" ::: "memory")
#define PG8_BAR __builtin_amdgcn_s_barrier()
#define PG8_SCHED __builtin_amdgcn_sched_barrier(0)
    Unit cur, nxt; int ui = 0;
    if (!S.next(0, cur)) return;
    f32x4 acc[2][2][4][2];
#pragma unroll
    for (int a = 0; a < 2; ++a)
#pragma unroll
        for (int b = 0; b < 2; ++b)
#pragma unroll
            for (int m = 0; m < 4; ++m)
#pragma unroll
                for (int n = 0; n < 2; ++n) acc[a][b][m][n] = (f32x4){0.f, 0.f, 0.f, 0.f};
    bf16x8 At[4][2], B0[2][2], B1[2][2];
    const char* cA = S.abase(cur); const char* cB = S.bbase(cur);
    PG8_STAGE(PG8_SB(0, 0), cB, voffB); PG8_STAGE(PG8_SB(0, 1), cB + hstepB, voffB); PG8_STAGE(PG8_SA(0, 0), cA, voffA); PG8_STAGE(PG8_SA(0, 1), cA + hstepA, voffA);
    if (wr == 1) PG8_BAR;
    PG8_WAIT_V(2); PG8_BAR;
    PG8_STAGE(PG8_SB(1, 0), cB + kstep, voffB); PG8_STAGE(PG8_SA(1, 0), cA + kstep, voffA); PG8_STAGE(PG8_SB(1, 1), cB + hstepB + kstep, voffB);
    PG8_WAIT_V(6); PG8_BAR;
    for (;;) {
        const bool has_next = S.next(ui + 1, nxt);
        const char* nA = has_next ? S.abase(nxt) : cA; const char* nB = has_next ? S.bbase(nxt) : cB;
        for (int t = 0; t < nt; t += 2) {
            const bool last = (t == nt - 2);
            const char* a1 = cA + (size_t)(t + 1) * kstep;
            const char* a2 = last ? nA : cA + (size_t)(t + 2) * kstep; const char* b2 = last ? nB : cB + (size_t)(t + 2) * kstep;
            const char* a3 = a2 + kstep; const char* b3 = b2 + kstep;
            PG8_LDB(B0, 0, 0); PG8_LDB(B1, 0, 1); PG8_SCHED; PG8_LDA(At, 0, 0); PG8_STAGE(PG8_SA(1, 1), a1 + hstepA, voffA);
            PG8_WAIT_V(8); PG8_WAIT_L(0); PG8_BAR; PG8_MMA(0, 0, At, B0); PG8_MMA(0, 1, At, B1); PG8_BAR; PG8_SCHED;
            PG8_LDA(At, 0, 1); PG8_STAGE(PG8_SB(0, 0), b2, voffB); PG8_STAGE(PG8_SB(0, 1), b2 + hstepB, voffB); PG8_STAGE(PG8_SA(0, 0), a2, voffA);
            PG8_WAIT_V(8); PG8_WAIT_L(0); PG8_BAR; PG8_MMA(1, 0, At, B0); PG8_MMA(1, 1, At, B1); PG8_BAR; PG8_SCHED;
            PG8_LDB(B0, 1, 0); PG8_LDB(B1, 1, 1); PG8_SCHED; PG8_LDA(At, 1, 0); PG8_STAGE(PG8_SA(0, 1), a2 + hstepA, voffA);
            PG8_WAIT_V(8); PG8_WAIT_L(0); PG8_BAR; PG8_MMA(0, 0, At, B0); PG8_MMA(0, 1, At, B1); PG8_BAR; PG8_SCHED;
            PG8_LDA(At, 1, 1); PG8_STAGE(PG8_SB(1, 0), b3, voffB); PG8_STAGE(PG8_SB(1, 1), b3 + hstepB, voffB); PG8_STAGE(PG8_SA(1, 0), a3, voffA);
            PG8_WAIT_V(8); PG8_WAIT_L(0); PG8_BAR; PG8_MMA(1, 0, At, B0); PG8_MMA(1, 1, At, B1); PG8_BAR; PG8_SCHED;
        }
        if constexpr (ALIGN_EPI) { if (wr == 0) PG8_BAR; }
        if constexpr (!Epi::AFTER_DRAIN) { E(acc, cur, wr, wc, fr, fq); }
        if (!has_next) break;
#pragma unroll
        for (int a = 0; a < 2; ++a)
#pragma unroll
            for (int b = 0; b < 2; ++b)
#pragma unroll
                for (int m = 0; m < 4; ++m)
#pragma unroll
                    for (int n = 0; n < 2; ++n) acc[a][b][m][n] = (f32x4){0.f, 0.f, 0.f, 0.f};
        cur = nxt; cA = nA; cB = nB; ++ui;
        if constexpr (ALIGN_EPI) { if (wr == 1) PG8_BAR; }
    }
    PG8_WAIT_V(0);
    if constexpr (!ALIGN_EPI) { if (wr == 0) PG8_BAR; }
    PG8_BAR;
    if constexpr (Epi::AFTER_DRAIN) { E.fused(acc, cur, wr, wc, fr, fq, lds, wid, lane); }
#undef PG8_SA
#undef PG8_SB
#undef PG8_STAGE
#undef PG8_LDA
#undef PG8_LDB
#undef PG8_MMA
#undef PG8_WAIT_V
#undef PG8_WAIT_L
#undef PG8_BAR
#undef PG8_SCHED
}
}

__device__ __forceinline__ void transpose_item(const float* W, int K, int N, bf16_t* WT, LAS float* scr, int item, int lane) {
    const int nblk = N / 64, kb = item / nblk, nb = item % nblk, k0 = 64 * kb, n0 = 64 * nb;
    f32x4 v[16];
#pragma unroll
    for (int i = 0; i < 16; ++i) v[i] = __builtin_nontemporal_load((const f32x4*)(W + (size_t)(k0 + 4 * i + (lane >> 4)) * N + n0 + 4 * (lane & 15)));
#pragma unroll
    for (int i = 0; i < 16; ++i) { LAS float* d = scr + (4 * i + (lane >> 4)) * 65 + 4 * (lane & 15); d[0] = v[i][0]; d[1] = v[i][1]; d[2] = v[i][2]; d[3] = v[i][3]; }
    LDS_WAIT(); asm volatile("" ::: "memory");
    const int c = lane & 7;
#pragma unroll
    for (int j = 0; j < 8; ++j) { const int n = (lane >> 3) + 8 * j; const LAS float* s = scr + (8 * c) * 65 + n;
        u32x4 o; o.x = pk2h(s[0 * 65], s[1 * 65]); o.y = pk2h(s[2 * 65], s[3 * 65]); o.z = pk2h(s[4 * 65], s[5 * 65]); o.w = pk2h(s[6 * 65], s[7 * 65]);
        *(u32x4*)(WT + (size_t)(n0 + n) * K + k0 + 8 * c) = o; }
    LDS_WAIT(); asm volatile("" ::: "memory");
}
__device__ __forceinline__ void rms_row_bf16(const float* xrow, const float* g, bf16_t* urow, int lane) {
    f32x4 v[8]; float ss = 0.f;
#pragma unroll
    for (int j = 0; j < 4; ++j) { v[2 * j] = *(const f32x4*)(xrow + j * 512 + lane * 8); v[2 * j + 1] = *(const f32x4*)(xrow + j * 512 + lane * 8 + 4); }
#pragma unroll
    for (int j = 0; j < 8; ++j) ss += (v[j][0] * v[j][0] + v[j][1] * v[j][1]) + (v[j][2] * v[j][2] + v[j][3] * v[j][3]);
    const float r = rsqrtf(wave_sum(ss) * (1.0f / D) + EPS);
#pragma unroll
    for (int j = 0; j < 4; ++j) { const f32x4 g0 = *(const f32x4*)(g + j * 512 + lane * 8), g1 = *(const f32x4*)(g + j * 512 + lane * 8 + 4); const f32x4 a = v[2 * j] * r * g0, b = v[2 * j + 1] * r * g1;
        u32x4 w; w.x = pk2h(a[0], a[1]); w.y = pk2h(a[2], a[3]); w.z = pk2h(b[0], b[1]); w.w = pk2h(b[2], b[3]); *(u32x4*)(urow + j * 512 + lane * 8) = w; }
}
template <bool SECOND, int XMODE, int UMODE = 0>
__device__ __forceinline__ void row_pass(const bf16_t* trow, const void* xrow_, void* orow_, const float* gpost, const float* gpre, bf16_t* urow, int lane, float* rsout = nullptr) {
    f32x4 t[8], xv[8]; float ss = 0.f;
    u32x4 tw_[4];
#pragma unroll
    for (int j = 0; j < 4; ++j) tw_[j] = *(const u32x4*)(trow + j * 512 + lane * 8);
#pragma unroll
    for (int jj = 0; jj < 4; ++jj) { const int off = jj * 512 + lane * 8;
        if (XMODE & 2) { const u32x4 w = *(const u32x4*)((const bf16_t*)xrow_ + off); xv[2 * jj] = (f32x4){bf_lo(w.x), bf_hi(w.x), bf_lo(w.y), bf_hi(w.y)}; xv[2 * jj + 1] = (f32x4){bf_lo(w.z), bf_hi(w.z), bf_lo(w.w), bf_hi(w.w)}; }
        else { xv[2 * jj] = *(const f32x4*)((const float*)xrow_ + off); xv[2 * jj + 1] = *(const f32x4*)((const float*)xrow_ + off + 4); } }
#pragma unroll
    for (int j = 0; j < 4; ++j) { const u32x4 w = tw_[j];
        t[2 * j] = (f32x4){bf_lo(w.x), bf_hi(w.x), bf_lo(w.y), bf_hi(w.y)}; t[2 * j + 1] = (f32x4){bf_lo(w.z), bf_hi(w.z), bf_lo(w.w), bf_hi(w.w)}; }
#pragma unroll
    for (int j = 0; j < 8; ++j) ss += (t[j][0] * t[j][0] + t[j][1] * t[j][1]) + (t[j][2] * t[j][2] + t[j][3] * t[j][3]);
    const float r = rsqrtf(wave_sum(ss) * (1.0f / D) + EPS);
    float ss2 = 0.f;
#pragma unroll
    for (int jj = 0; jj < 4; ++jj) { const int off = jj * 512 + lane * 8; const f32x4 x0 = xv[2 * jj], x1 = xv[2 * jj + 1];
        const f32x4 g0 = *(const f32x4*)(gpost + off), g1 = *(const f32x4*)(gpost + off + 4);
        const f32x4 a = x0 + t[2 * jj] * r * g0, b = x1 + t[2 * jj + 1] * r * g1; t[2 * jj] = a; t[2 * jj + 1] = b;
        if (XMODE & 1) { u32x4 w; w.x = pk2h(a[0], a[1]); w.y = pk2h(a[2], a[3]); w.z = pk2h(b[0], b[1]); w.w = pk2h(b[2], b[3]); *(u32x4*)((bf16_t*)orow_ + off) = w; }
        else { *(f32x4*)((float*)orow_ + off) = a; *(f32x4*)((float*)orow_ + off + 4) = b; }
        ss2 += (a[0] * a[0] + a[1] * a[1]) + (a[2] * a[2] + a[3] * a[3]) + (b[0] * b[0] + b[1] * b[1]) + (b[2] * b[2] + b[3] * b[3]); }
    if (SECOND) {
        const float r2 = rsqrtf(wave_sum(ss2) * (1.0f / D) + EPS);
        if (UMODE == 1) { if (lane == 0) *rsout = r2; return; }
#pragma unroll
        for (int j = 0; j < 4; ++j) { const f32x4 g0 = *(const f32x4*)(gpre + j * 512 + lane * 8), g1 = *(const f32x4*)(gpre + j * 512 + lane * 8 + 4); const f32x4 a = t[2 * j] * r2 * g0, b = t[2 * j + 1] * r2 * g1;
            u32x4 w; w.x = pk2h(a[0], a[1]); w.y = pk2h(a[2], a[3]); w.z = pk2h(b[0], b[1]); w.w = pk2h(b[2], b[3]); *(u32x4*)(urow + j * 512 + lane * 8) = w; }
    }
}


__device__ __forceinline__ void final_row_pass(const bf16_t* trow, float* slot, const float* gpost, int lane) {
    u32x4 tw[4], xw[4];
#pragma unroll
    for (int j = 0; j < 4; ++j) { tw[j] = *(const u32x4*)(trow + j * 512 + lane * 8); xw[j] = *(const u32x4*)((const bf16_t*)slot + D + j * 512 + lane * 8); }
    asm volatile("s_waitcnt vmcnt(0)" ::: "memory");
    float ss = 0.f;
#pragma unroll
    for (int j = 0; j < 4; ++j) { const u32x4 w = tw[j]; const float a0 = bf_lo(w.x), a1 = bf_hi(w.x), a2 = bf_lo(w.y), a3 = bf_hi(w.y), a4 = bf_lo(w.z), a5 = bf_hi(w.z), a6 = bf_lo(w.w), a7 = bf_hi(w.w);
        ss += (a0 * a0 + a1 * a1) + (a2 * a2 + a3 * a3) + (a4 * a4 + a5 * a5) + (a6 * a6 + a7 * a7); }
    const float r = rsqrtf(wave_sum(ss) * (1.0f / D) + EPS);
#pragma unroll
    for (int j = 0; j < 4; ++j) { const int off = j * 512 + lane * 8; const u32x4 w = tw[j], x = xw[j];
        const f32x4 g0 = *(const f32x4*)(gpost + off), g1 = *(const f32x4*)(gpost + off + 4);
        const f32x4 t0 = (f32x4){bf_lo(w.x), bf_hi(w.x), bf_lo(w.y), bf_hi(w.y)}, t1 = (f32x4){bf_lo(w.z), bf_hi(w.z), bf_lo(w.w), bf_hi(w.w)};
        const f32x4 x0 = (f32x4){bf_lo(x.x), bf_hi(x.x), bf_lo(x.y), bf_hi(x.y)}, x1 = (f32x4){bf_lo(x.z), bf_hi(x.z), bf_lo(x.w), bf_hi(x.w)};
        *(f32x4*)(slot + off) = x0 + t0 * r * g0; *(f32x4*)(slot + off + 4) = x1 + t1 * r * g1; }
}

template <int KC>
__device__ __forceinline__ f32x16 thin_mac_lds(LAS unsigned char* lds, const bf16_t* A, const bf16_t* Bt, int K, int tid, int wid, int lane) {
    constexpr int NP = KC / 128, SH = (KC == 1024) ? 7 : 6, RS = 2 * KC + 16;
    LAS unsigned char* LA = lds; LAS unsigned char* LB = lds + 32 * RS;
    const int r = lane & 31, hh = lane >> 5;
    f32x16 acc;
#pragma unroll
    for (int e = 0; e < 16; ++e) acc[e] = 0.f;
    u32x4 ra[NP], rb[NP];
    const int prow = tid >> SH, pc8 = tid & ((1 << SH) - 1);
    const bf16_t* ga = A + (size_t)prow * K + pc8 * 8; const bf16_t* gb = Bt + (size_t)prow * K + pc8 * 8;
    const size_t gstep = (size_t)(512 >> SH) * K;
#pragma unroll
    for (int i = 0; i < NP; ++i) { ra[i] = *(const u32x4*)(ga + i * gstep); rb[i] = *(const u32x4*)(gb + i * gstep); }
    for (int k0 = 0; k0 < K; k0 += KC) {
        __syncthreads();
#pragma unroll
        for (int i = 0; i < NP; ++i) { const int row = prow + i * (512 >> SH); *(LAS u32x4*)(LA + row * RS + pc8 * 16) = ra[i]; *(LAS u32x4*)(LB + row * RS + pc8 * 16) = rb[i]; }
        __syncthreads();
        if (k0 + KC < K) {
#pragma unroll
            for (int i = 0; i < NP; ++i) { ra[i] = *(const u32x4*)(ga + i * gstep + k0 + KC); rb[i] = *(const u32x4*)(gb + i * gstep + k0 + KC); } }
        const int ks = wid * (KC / 8);
#pragma unroll
        for (int s2 = 0; s2 < KC / 128; ++s2) { const bf16x8 a = *(const LAS bf16x8*)(LA + r * RS + (ks + 16 * s2 + 8 * hh) * 2), b = *(const LAS bf16x8*)(LB + r * RS + (ks + 16 * s2 + 8 * hh) * 2);
            acc = __builtin_amdgcn_mfma_f32_32x32x16_bf16(a, b, acc, 0, 0, 0); }
    }
    return acc;
}
__device__ __forceinline__ void thin_put(LAS float* red, const f32x16& acc, int wid, int lane) {
    const int col = lane & 31, hh = lane >> 5;
#pragma unroll
    for (int e = 0; e < 16; ++e) red[wid * 1024 + ((e & 3) + 8 * (e >> 2) + 4 * hh) * 32 + col] = acc[e];
}
__device__ __forceinline__ void thin_get(const LAS float* red, int tid, float& v0, float& v1) {
    const int o = (tid >> 4) * 32 + (tid & 15) * 2; v0 = 0.f; v1 = 0.f;
#pragma unroll
    for (int w = 0; w < 8; ++w) { v0 += red[w * 1024 + o]; v1 += red[w * 1024 + o + 1]; }
}
template <int KC>
__device__ __forceinline__ void thin_gemm_bf16(LAS unsigned char* lds, const bf16_t* A, const bf16_t* Bt, int K, bf16_t* O, int c, int tid, int wid, int lane) {
    const int r0 = SEQ + 32 * ((c >> 3) & 3), c0 = 32 * (8 * (c & 7) + (c >> 5)), kw = K / 8;
    LAS float* red = (LAS float*)lds;
    const f32x16 acc = thin_mac_lds<KC>(lds, A + (size_t)r0 * K, Bt + (size_t)c0 * K, K, tid, wid, lane); (void)kw;
    __syncthreads();
    thin_put(red, acc, wid, lane);
    __syncthreads();
    float v0, v1; thin_get(red, tid, v0, v1);
    *(unsigned*)(O + (size_t)(r0 + (tid >> 4)) * D + c0 + (tid & 15) * 2) = pk2(v0, v1);
    __syncthreads();
}

__global__ void __launch_bounds__(512, 2) mega(Params p) {
    extern __shared__ __attribute__((aligned(16))) unsigned char lds_raw[];
    LAS unsigned char* lds = (LAS unsigned char*)lds_raw;
    cg::grid_group grid = cg::this_grid();
    const int wid0_ = __builtin_amdgcn_readfirstlane((int)(threadIdx.x >> 6));
#define IN(k) (p.ph_lo <= (k) && (k) < p.ph_hi)
#define PHASE_VARS int tid = (wid0_ << 6) | lane_id_(); asm volatile("" : "+v"(tid)); const int lane = tid & 63, wid = __builtin_amdgcn_readfirstlane(tid >> 6), c = blockIdx.x, G = gridDim.x; const int gw = c * 8 + wid, NGW = G * 8; (void)lane; (void)gw; (void)NGW;
#if USE_XCD_BAR
    volatile LAS unsigned* bst = (volatile LAS unsigned*)(lds + LDS_BYTES - 16);
    if (threadIdx.x < 4) bst[threadIdx.x] = 0u;
    __syncthreads();
    XcdBarrier xbar = xcd_barrier_post((unsigned*)(p.ws + WS_BAR), bst);
#define SEAM(k) do { if (IN(k) && IN((k) + 1)) { xcd_barrier(xbar, ((wid0_ << 6) | lane_id_()) == 0); } } while (0)
#else
#define SEAM(k) do { if (IN(k) && IN((k) + 1)) grid.sync(); } while (0)
#endif
#define out (p.out)
#define WSP(off) ((bf16_t*)(p.ws + (off)))
#define WinT WSP(WS_WIN)
#define WkvT WSP(WS_WKV)
#define WpaT WSP(WS_WPA)
#define WpbT WSP(WS_WPB)
#define WoT WSP(WS_WO)
#define WqT WSP(WS_WQ)
#define WxoT WSP(WS_WXO)
#define WrT WSP(WS_WR)
#define WiT WSP(WS_WI)
#define WupT WSP(WS_T)
#define WdnT WSP(WS_WDN)
#define KB WSP(WS_KB)
#define VB WSP(WS_VT)
#define NT WSP(WS_END)
#define WqN WSP(WS_END + 4194304)
#define MT WSP(WS_END + 12582912)
#define RS1 ((float*)(p.ws + WS_END + 16777216))
#define MN WSP(WS_MN)
#define PSP ((float*)(p.ws + WS_PSP))
#define PSS ((float*)(p.ws + WS_PSS))
#define PS2 ((unsigned long long*)(p.ws + WS_PSP))
#define FLG ((unsigned*)(p.ws + WS_BAR + 16384))
#define Z WSP(WS_Z)
#define UP WSP(WS_Z)
#define X1B WSP(WS_Z)
#define T WSP(WS_T)
#define U WSP(B1)
#define HLOC WSP(B1)
#define MIX WSP(B1)
#define Qb WSP(B1)
#define CP WSP(B2)
#define U2 WSP(B2)
#define Ob WSP(B2)
#define HA WSP(B3)
#define Pb WSP(B3)
#define HBb WSP(B4)
#define U3 WSP(B1)
#define T2 WSP(B3)
#define Gb WSP(WS_G)
    if (IN(0)) { PHASE_VARS
        LAS float* scr = (LAS float*)(lds + wid * 16896);
        constexpr int I_IN = 32 * 176, I_SQ = 32 * 32, I_PB = 16 * 32, I_BD = 64;
        constexpr int NIT = I_IN + 2 * I_SQ + 2 * I_BD;
        for (int it = gw; it < NIT; it += NGW) {
            int r = it;
            if (r < I_IN) { transpose_item(p.in[11], D, NIN, WinT, scr, r, lane); continue; } r -= I_IN;
            if (r < I_SQ) { transpose_item(p.in[27], D, D, WkvT, scr, r, lane); continue; } r -= I_SQ;
            if (r < I_SQ) { transpose_item(p.in[28], D, D, WkvT + (size_t)D * D, scr, r, lane); continue; } r -= I_SQ;
            if (r < I_BD) { const int hh = r >> 2; transpose_item(p.in[14] + hh * 16384, 128, 128, WrT + hh * 16384, scr, r & 3, lane); continue; } r -= I_BD;
            { const int hh = r >> 2; transpose_item(p.in[16] + hh * 16384, 128, 128, WiT + hh * 16384, scr, r & 3, lane); }
        }
        for (int m = gw; m < MP + NMEM; m += NGW) {
            if (m < SEQ) rms_row_bf16(p.in[0] + (size_t)m * D, p.in[9], U + (size_t)m * D, lane);
            else if (m < MR) rms_row_bf16(p.in[1] + (size_t)(m - SEQ) * D, p.in[9], U + (size_t)m * D, lane);
            else if (m < MP) {
#pragma unroll
                for (int j = 0; j < 4; ++j) *(u32x4*)(U + (size_t)m * D + j * 512 + lane * 8) = (u32x4){0u, 0u, 0u, 0u}; }
            else rms_row_bf16(p.in[2] + (size_t)(m - MP) * D, p.in[25], MN + (size_t)(m - MP) * D, lane);
        }
    }
    SEAM(0);
    if (IN(1)) { PHASE_VARS
        { pg8::GridSched S; S.init(U, WinT, MP, NIN, D, D, G, c); pg8::EpiBf16 E{Z, NIN}; pg8::gemm_phase(lds, S, E, D, D, D, tid); }
        { pg8::GridSched S; S.init(MN, WkvT, NMEM, 2 * D, D, D, G, (c + G - 172) % G); pg8::EpiKV E{out + O_PMK, out + O_PMV, KB, VB}; pg8::gemm_phase(lds, S, E, D, D, D, tid); }
        if (c >= 196) {
            __syncthreads();
            LAS float* scr = (LAS float*)(lds + wid * 16896);
            constexpr int I_SQ = 32 * 32, I_PB = 16 * 32;
            for (int it = (c - 196) * 8 + wid; it < 4 * I_SQ + I_PB; it += (G - 196) * 8) {
                int r = it;
                if (r < I_SQ) { transpose_item(p.in[20], D, D, WpaT, scr, r, lane); continue; } r -= I_SQ;
                if (r < I_SQ) { transpose_item(p.in[22], D, D, WoT, scr, r, lane); continue; } r -= I_SQ;
                if (r < I_SQ) { transpose_item(p.in[26], D, D, WqT, scr, r, lane); continue; } r -= I_SQ;
                if (r < I_SQ) { transpose_item(p.in[29], D, D, WxoT, scr, r, lane); continue; } r -= I_SQ;
                transpose_item(p.in[21], DC, D, WpbT, scr, r, lane);
            }
            {
                const float* wq = p.in[26];
                for (int i = (c - 196) * 8 + wid; i < D * D / 512; i += (G - 196) * 8) { const float gq_ = p.in[23][i >> 2]; const f32x4 a = gq_ * __builtin_nontemporal_load((const f32x4*)(wq + (size_t)i * 512 + lane * 8)), b = gq_ * __builtin_nontemporal_load((const f32x4*)(wq + (size_t)i * 512 + lane * 8 + 4));
                    u32x4 w; w.x = pk2h(a[0], a[1]); w.y = pk2h(a[2], a[3]); w.z = pk2h(b[0], b[1]); w.w = pk2h(b[2], b[3]); *(u32x4*)(WqN + (size_t)i * 512 + lane * 8) = w; }
            }
        }
    }
    SEAM(1);
    if (IN(2)) { PHASE_VARS
        {
            const int h = c & 15;
            LAS unsigned char* WR = lds; LAS unsigned char* WI = lds + 34816; LAS unsigned char* XA = lds + 69632;
            LAS float* Ab = (LAS float*)(lds + 87040); LAS float* Bb = (LAS float*)(lds + 87040 + 32768);
            LAS float* SEGP = (LAS float*)(lds + 69632); LAS float* SEGS = (LAS float*)(lds + 69632 + 2048);
            for (int q = tid; q < 2048; q += 512) { const int j = q >> 4, ck = q & 15;
                *(LAS u32x4*)(WR + j * 272 + ck * 16) = *(const u32x4*)(WrT + h * 16384 + j * 128 + ck * 8);
                *(LAS u32x4*)(WI + j * 272 + ck * 16) = *(const u32x4*)(WiT + h * 16384 + j * 128 + ck * 8); }
            const int i2 = tid & 63, tg = tid >> 6, chc = h * 128 + 2 * i2;
            float cw[4][2];
#pragma unroll
            for (int k = 0; k < 4; ++k) { cw[k][0] = p.in[12][k * D + chc]; cw[k][1] = p.in[12][k * D + chc + 1]; }
            const float cb0 = p.in[13][chc], cb1 = p.in[13][chc + 1];
            const int mb = wid & 1, nb = wid >> 1, l31 = lane & 31, hh = lane >> 5, jg = 32 * nb + l31, chg = h * 128 + jg;
            const float br = p.in[15][chg], bi = p.in[17][chg];
            const float sp8 = -8.0f * log1pf(__expf(-p.in[18][chg]));
            const int seg = tid >> 7, sch = tid & 127, schg = h * 128 + sch;
            unsigned zr[11];
#define ZR_ISSUE(ccn) do { _Pragma("unroll") for (int k = 0; k < 11; ++k) { const int grow = (ccn) * 64 + tg * 8 - 3 + k; zr[k] = grow >= 0 ? *(const unsigned*)(Z + (size_t)grow * NIN + chc) : 0u; } } while (0)
            if ((c >> 4) < 128) ZR_ISSUE(c >> 4);
            float carry_run = 0.f;
            LAS float* CARR = (LAS float*)(lds + 69632 + 4096);
            for (int cc = c >> 4; cc < NCHUNK; cc += 16) {
                const int r0 = cc * 64; const bool smp = cc >= 128;
                __syncthreads();
                {
                    float ra[11], rb[11]; const int t0 = tg * 8;
                    if (!smp) {
#pragma unroll
                        for (int k = 0; k < 11; ++k) { ra[k] = bf_lo(zr[k]); rb[k] = bf_hi(zr[k]); }
                        if (cc + 16 < 128) ZR_ISSUE(cc + 16);
                    } else {
#pragma unroll
                        for (int k = 0; k < 11; ++k) { const int pp = (t0 & 15) - 3 + k, b = (r0 - SEQ + t0) >> 4;
                            if (pp >= 0) { const unsigned u = *(const unsigned*)(Z + (size_t)(SEQ + b * 16 + pp) * NIN + chc); ra[k] = bf_lo(u); rb[k] = bf_hi(u); }
                            else { const float* sp = p.in[3] + (size_t)(b * 3 + 3 + pp) * D + chc; ra[k] = sp[0]; rb[k] = sp[1]; } }
                    }
#pragma unroll
                    for (int j = 0; j < 8; ++j) { const float o0 = cb0 + cw[0][0] * ra[j] + cw[1][0] * ra[j + 1] + cw[2][0] * ra[j + 2] + cw[3][0] * ra[j + 3];
                        const float o1 = cb1 + cw[0][1] * rb[j] + cw[1][1] * rb[j + 1] + cw[2][1] * rb[j + 2] + cw[3][1] * rb[j + 3];
                        *(LAS unsigned*)(XA + (t0 + j) * 272 + i2 * 4) = pk2h(o0, o1); }
                }
                __syncthreads();
                {
                    f32x16 accR, accI;
#pragma unroll
                    for (int e = 0; e < 16; ++e) { accR[e] = 0.f; accI[e] = 0.f; }
#pragma unroll
                    for (int kk = 0; kk < 8; ++kk) {
                        const bf16x8 a = *(const LAS bf16x8*)(XA + (32 * mb + l31) * 272 + (16 * kk + 8 * hh) * 2);
                        const bf16x8 b0 = *(const LAS bf16x8*)(WR + (32 * nb + l31) * 272 + (16 * kk + 8 * hh) * 2);
                        const bf16x8 b1 = *(const LAS bf16x8*)(WI + (32 * nb + l31) * 272 + (16 * kk + 8 * hh) * 2);
                        accR = __builtin_amdgcn_mfma_f32_32x32x16_bf16(a, b0, accR, 0, 0, 0);
                        accI = __builtin_amdgcn_mfma_f32_32x32x16_bf16(a, b1, accI, 0, 0, 0);
                    }
#pragma unroll
                    for (int e = 0; e < 16; ++e) { const int t = 32 * mb + (e & 3) + 8 * (e >> 2) + 4 * hh;
                        const float rr = sigmoidf_(accR[e] + br), ii = sigmoidf_(accI[e] + bi);
                        const float la = sp8 * rr; const float a = __expf(la); float mult = __builtin_amdgcn_sqrtf(1.0f - a * a);
                        if (r0 + t == 0) mult = 1.0f;
                        const float xv = bf1(*(const LAS bf16_t*)(XA + t * 272 + jg * 2));
                        Ab[t * 128 + jg] = a; Bb[t * 128 + jg] = mult * ii * xv; }
                }
                const bf16_t* gap_ = Z + (size_t)(r0 + (tid >> 3)) * NIN + Z_GA + h * 128 + (tid & 7) * 16;
                const u32x4 gq0 = *(const u32x4*)gap_, gq1 = *(const u32x4*)(gap_ + 8);
                __syncthreads();
                if (!smp) {
                    float Pp = 1.f, Ss = 0.f;
#pragma unroll
                    for (int t = 0; t < 16; ++t) { const float a = Ab[(seg * 16 + t) * 128 + sch], b = Bb[(seg * 16 + t) * 128 + sch]; Ss = a * Ss + b; Pp *= a; }
                    SEGP[seg * 128 + sch] = Pp; SEGS[seg * 128 + sch] = Ss;
                    __syncthreads();
                    float cp = 1.f, hv = 0.f;
                    for (int s2 = 0; s2 < seg; ++s2) { const float pp = SEGP[s2 * 128 + sch], ss = SEGS[s2 * 128 + sch]; hv = pp * hv + ss; cp *= pp; }
#pragma unroll
                    for (int t = 0; t < 16; ++t) { const int o = (seg * 16 + t) * 128 + sch; const float a = Ab[o], b = Bb[o]; hv = a * hv + b; cp *= a; Ab[o] = hv; Bb[o] = cp; }
                    if (seg == 3) __hip_atomic_store(PS2 + (size_t)cc * D + schg, ((unsigned long long)__float_as_uint(hv) << 32) | __float_as_uint(cp), __ATOMIC_RELAXED, __HIP_MEMORY_SCOPE_AGENT);
                } else {
                    const int b = (cc - 128) * 4 + seg; float hv = p.in[4][b * D + schg];
#pragma unroll
                    for (int t = 0; t < 16; ++t) { const int o = (seg * 16 + t) * 128 + sch; const float a = Ab[o], bb = Bb[o]; hv = a * hv + bb; Ab[o] = hv; Bb[o] = 0.f; }
                    out[O_SRH + b * D + schg] = hv;
                    __syncthreads();
                }
                asm volatile("s_waitcnt vmcnt(0)" ::: "memory");
                __syncthreads();
                if (!smp) {
                    if (tid == 0) __hip_atomic_store(FLG + cc * 16 + h, 1u, __ATOMIC_RELAXED, __HIP_MEMORY_SCOPE_AGENT);
                    const int lo = cc < 16 ? 0 : cc - 16;
                    if (wid == 1) {
                        const int j = lo + lane;
                        if (j < cc) { unsigned spn = 0u; while (__hip_atomic_load(FLG + j * 16 + h, __ATOMIC_RELAXED, __HIP_MEMORY_SCOPE_AGENT) == 0u) { __builtin_amdgcn_s_sleep(1); if (++spn > (1u << 22)) break; } }
                    }
                    __syncthreads();
                    if (tid < 128) {
                        float pj[16], sj[16]; const int jmax = cc > 0 ? cc - 1 : 0;
#pragma unroll
                        for (int i = 0; i < 16; ++i) { const int jj = (lo + i) < jmax ? (lo + i) : jmax; const unsigned long long v = __hip_atomic_load(PS2 + (size_t)jj * D + h * 128 + tid, __ATOMIC_RELAXED, __HIP_MEMORY_SCOPE_AGENT); pj[i] = __uint_as_float((unsigned)v); sj[i] = __uint_as_float((unsigned)(v >> 32)); }
                        float cr = carry_run;
#pragma unroll
                        for (int i = 0; i < 16; ++i) cr = ((lo + i) < cc) ? pj[i] * cr + sj[i] : cr;
                        carry_run = cr; CARR[tid] = cr;
                        if (cc == 127) out[O_PRH + h * 128 + tid] = Ab[63 * 128 + tid] + Bb[63 * 128 + tid] * cr;
                    }
                } else { if (tid < 128) CARR[tid] = 0.f; }
                __syncthreads();
                {
                    const int row = tid >> 3, c16 = (tid & 7) * 16; const size_t o = (size_t)(r0 + row) * D + h * 128 + c16;
                    const LAS float* ha = Ab + row * 128 + c16; const LAS float* ca = Bb + row * 128 + c16; const LAS float* cr = CARR + c16;
                    float ov[16];
#pragma unroll
                    for (int q4 = 0; q4 < 4; ++q4) { const f32x4 hv4 = *(const LAS f32x4*)(ha + 4 * q4), cp4 = *(const LAS f32x4*)(ca + 4 * q4), cr4 = *(const LAS f32x4*)(cr + 4 * q4);
                        const unsigned g01 = q4 < 2 ? (q4 == 0 ? gq0.x : gq0.z) : (q4 == 2 ? gq1.x : gq1.z), g23 = q4 < 2 ? (q4 == 0 ? gq0.y : gq0.w) : (q4 == 2 ? gq1.y : gq1.w);
                        ov[4 * q4 + 0] = (hv4[0] + cp4[0] * cr4[0]) * gelu_tanh(bf_lo(g01)); ov[4 * q4 + 1] = (hv4[1] + cp4[1] * cr4[1]) * gelu_tanh(bf_hi(g01));
                        ov[4 * q4 + 2] = (hv4[2] + cp4[2] * cr4[2]) * gelu_tanh(bf_lo(g23)); ov[4 * q4 + 3] = (hv4[3] + cp4[3] * cr4[3]) * gelu_tanh(bf_hi(g23)); }
                    const u32x4 w0 = (u32x4){pk2h(ov[0], ov[1]), pk2h(ov[2], ov[3]), pk2h(ov[4], ov[5]), pk2h(ov[6], ov[7])}, w1 = (u32x4){pk2h(ov[8], ov[9]), pk2h(ov[10], ov[11]), pk2h(ov[12], ov[13]), pk2h(ov[14], ov[15])};
                    *(u32x4*)(HA + o) = w0; *(u32x4*)(HA + o + 8) = w1;
                }
            }
#undef ZR_ISSUE
        }
        if (c >= 32 && c < 64) {
            __syncthreads();
            pg8::MTSched S{c - 32, (const char*)KB, (const char*)WqN}; pg8::EpiBf16 E{MT, 8192}; pg8::gemm_phase(lds, S, E, 512, D, D, tid);
        }
        for (int w = c * 512 + tid; w < (MR / 16) * 256; w += G * 512) {
            const int rg = w >> 8, ch = (w & 255) * 4, r0 = rg * 16; const bool smp = r0 >= SEQ; const int b = (r0 - SEQ) >> 4;
            const f32x4 w0 = *(const f32x4*)(p.in[19] + ch), w1 = *(const f32x4*)(p.in[19] + DC + ch), w2 = *(const f32x4*)(p.in[19] + 2 * DC + ch);
            f32x4 m2, m1;
            if (smp) { m2 = *(const f32x4*)(p.in[5] + (size_t)b * 2 * DC + ch); m1 = *(const f32x4*)(p.in[5] + (size_t)b * 2 * DC + DC + ch); }
            else if (r0 == 0) { m2 = (f32x4){0.f, 0.f, 0.f, 0.f}; m1 = m2; }
            else { const bf16_t* z2 = Z + (size_t)(r0 - 2) * NIN + ch; const bf16_t* z1 = z2 + NIN;
                const u32x2 g2 = *(const u32x2*)(z2 + Z_GC), h2 = *(const u32x2*)(z2 + Z_HB), g1 = *(const u32x2*)(z1 + Z_GC), h1 = *(const u32x2*)(z1 + Z_HB);
                m2 = (f32x4){bf_lo(g2.x) * bf_lo(h2.x), bf_hi(g2.x) * bf_hi(h2.x), bf_lo(g2.y) * bf_lo(h2.y), bf_hi(g2.y) * bf_hi(h2.y)};
                m1 = (f32x4){bf_lo(g1.x) * bf_lo(h1.x), bf_hi(g1.x) * bf_hi(h1.x), bf_lo(g1.y) * bf_lo(h1.y), bf_hi(g1.y) * bf_hi(h1.y)}; }
#pragma unroll 8
            for (int t = 0; t < 16; ++t) { const bf16_t* z = Z + (size_t)(r0 + t) * NIN + ch;
                const u32x2 gc = *(const u32x2*)(z + Z_GC), hb = *(const u32x2*)(z + Z_HB), gb = *(const u32x2*)(z + Z_GB);
                const f32x4 cv = (f32x4){bf_lo(gc.x) * bf_lo(hb.x), bf_hi(gc.x) * bf_hi(hb.x), bf_lo(gc.y) * bf_lo(hb.y), bf_hi(gc.y) * bf_hi(hb.y)};
                const f32x4 gbf = (f32x4){bf_lo(gb.x), bf_hi(gb.x), bf_lo(gb.y), bf_hi(gb.y)};
                const f32x4 o = gbf * (w0 * m2 + w1 * m1 + w2 * cv);
                u32x2 ow; ow.x = pk2h(o[0], o[1]); ow.y = pk2h(o[2], o[3]); *(u32x2*)(HBb + (size_t)(r0 + t) * DC + ch) = ow;
                m2 = m1; m1 = cv; }
            if (smp) { float* o = out + O_SCB + (size_t)b * 2 * DC + ch; *(f32x4*)o = m2; *(f32x4*)(o + DC) = m1; }
            else if (r0 == SEQ - 16) { float* o = out + O_PCB + ch; *(f32x4*)o = m2; *(f32x4*)(o + DC) = m1; }
        }
        for (int e = c * 512 + tid; e < 9 * 3 * D; e += G * 512) { const int ch = e % D, k = (e / D) % 3, s = e / (3 * D);
            if (s == 0) out[O_PCA + k * D + ch] = bf1(Z[(size_t)(SEQ - 3 + k) * NIN + ch]);
            else out[O_SCA + (size_t)((s - 1) * 3 + k) * D + ch] = bf1(Z[(size_t)(SEQ + (s - 1) * 16 + 13 + k) * NIN + ch]); }
    }
    SEAM(2);
    if (IN(4)) { PHASE_VARS
        {
            const int r0 = SEQ + 32 * ((c >> 3) & 3), c0 = 32 * (8 * (c & 7) + (c >> 5));
            LAS float* red = (LAS float*)lds;
            const f32x16 accA = thin_mac_lds<1024>(lds, HA + (size_t)r0 * D, WpaT + (size_t)c0 * D, D, tid, wid, lane);
            const f32x16 accB = thin_mac_lds<1024>(lds, HBb + (size_t)r0 * DC, WpbT + (size_t)c0 * DC, DC, tid, wid, lane);
            __syncthreads();
            thin_put(red, accA, wid, lane);
            thin_put(red + 8192, accB, wid, lane);
            __syncthreads();
            float a0, a1, b0, b1; thin_get(red, tid, a0, a1); thin_get(red + 8192, tid, b0, b1);
            const int row = r0 + (tid >> 4), col = c0 + (tid & 15) * 2;
            const unsigned ga = *(const unsigned*)(Z + (size_t)row * NIN + Z_GATEA + col), gb = *(const unsigned*)(Z + (size_t)row * NIN + Z_GATEB + col);
            *(unsigned*)(MIX + (size_t)row * D + col) = pk2h(sigmoidf_(bf_lo(ga)) * a0 + sigmoidf_(bf_lo(gb)) * b0, sigmoidf_(bf_hi(ga)) * a1 + sigmoidf_(bf_hi(gb)) * b1);
            __syncthreads();
        }
#pragma unroll 1
        for (int pass_ = 0; pass_ < 2; ++pass_) {
            const bf16_t* A_ = pass_ ? HBb : HA; const bf16_t* B_ = pass_ ? WpbT : WpaT; const int K_ = pass_ ? DC : D;
            pg8::GridSched S; S.init(A_, B_, SEQ, D, K_, K_, G, c); pg8::EpiMix E{Z, MIX, pass_}; pg8::gemm_phase(lds, S, E, K_, K_, K_, tid);
        }
    }
    SEAM(4);
    if (IN(5)) { PHASE_VARS thin_gemm_bf16<1024>(lds, MIX, WoT, D, T, c, tid, wid, lane); pg8::GridSched S; S.init(MIX, WoT, SEQ, D, D, D, G, c); pg8::EpiBf16 E{T, D}; pg8::gemm_phase(lds, S, E, D, D, D, tid); }
    SEAM(5);
    if (IN(6)) { PHASE_VARS
        for (int m = gw; m < MR; m += NGW) { const float* xr = m < SEQ ? p.in[0] + (size_t)m * D : p.in[1] + (size_t)(m - SEQ) * D;
            if (m < SEQ) row_pass<true, 1, 1>(T + (size_t)m * D, xr, X1B + (size_t)m * D, p.in[10], p.in[23], nullptr, lane, RS1 + m);
            else row_pass<true, 1, 0>(T + (size_t)m * D, xr, X1B + (size_t)m * D, p.in[10], p.in[23], U2 + (size_t)m * D, lane); }
    }
    SEAM(6);
    if (IN(7)) { PHASE_VARS thin_gemm_bf16<1024>(lds, U2, WqT, D, Qb, c, tid, wid, lane); }
    SEAM(7);
    if (IN(8)) { PHASE_VARS
        if (c < 128) {
            pg8::AttnSSched S{G, c, (const char*)X1B, (const char*)MT}; pg8::EpiSoftmax E{Pb, 1024, 0.044194173824159216f * 1.4426950408889634f, RS1};
            pg8::gemm_phase(lds, S, E, D, D, 8192, tid);
        } else {
            if (c >= 192) {
                LAS float* scr = (LAS float*)(lds + wid * 16896);
                for (int it = (c - 192) * 8 + wid; it < 32 * 176; it += (G - 192) * 8) transpose_item(p.in[32], D, NUP, WupT, scr, it, lane);
            } else if (c >= 160) {
                pg8::NTSched S{c - 160, (const char*)WxoT, (const char*)VB}; pg8::EpiBf16 E{NT, 1024}; pg8::gemm_phase(lds, S, E, 512, D, D, tid);
            }
            for (int it = c - 128; it < 32; it += (G - 128)) {
                const int b = it >> 2, h = it & 3, R0 = SEQ + b * 16, fr = lane & 15, fq = lane >> 4;
                LAS float* Sc = (LAS float*)lds; LAS float* Pt = (LAS float*)(lds + 16384);
                __syncthreads();
                {
                    bf16x8 qf[16];
#pragma unroll
                    for (int s = 0; s < 16; ++s) qf[s] = *(const bf16x8*)(Qb + (size_t)(R0 + fr) * D + h * 512 + s * 32 + fq * 8);
#pragma unroll
                    for (int kb2 = 0; kb2 < 2; ++kb2) { const int key = (wid * 2 + kb2) * 16 + fr; f32x4 acc = (f32x4){0.f, 0.f, 0.f, 0.f};
                        const float* kp = p.in[7] + ((size_t)(b * 256 + key) * 4 + h) * 512 + fq * 8;
#pragma unroll
                        for (int s = 0; s < 16; ++s) { const f32x4 k0 = *(const f32x4*)(kp + s * 32), k1 = *(const f32x4*)(kp + s * 32 + 4);
                            u32x4 w; w.x = pk2h(k0[0], k0[1]); w.y = pk2h(k0[2], k0[3]); w.z = pk2h(k1[0], k1[1]); w.w = pk2h(k1[2], k1[3]);
                            acc = __builtin_amdgcn_mfma_f32_16x16x32_bf16(qf[s], __builtin_bit_cast(bf16x8, w), acc, 0, 0, 0); }
#pragma unroll
                        for (int e = 0; e < 4; ++e) Sc[(4 * fq + e) * 256 + key] = acc[e] * 0.044194173824159216f; }
                }
                __syncthreads();
#pragma unroll
                for (int qq = 0; qq < 2; ++qq) { const int q = wid * 2 + qq; float v[4]; float mx = -3.0e38f;
#pragma unroll
                    for (int i = 0; i < 4; ++i) { v[i] = Sc[q * 256 + lane + 64 * i]; mx = fmaxf(mx, v[i]); }
                    mx = wave_max(mx); float s = 0.f;
#pragma unroll
                    for (int i = 0; i < 4; ++i) { v[i] = __expf(v[i] - mx); s += v[i]; }
                    s = 1.0f / wave_sum(s);
#pragma unroll
                    for (int i = 0; i < 4; ++i) Pt[(lane + 64 * i) * 16 + q] = v[i] * s; }
                __syncthreads();
                {
                    float acc[16];
#pragma unroll
                    for (int q = 0; q < 16; ++q) acc[q] = 0.f;
                    const float* vp = p.in[8] + ((size_t)(b * 256) * 4 + h) * 512 + tid;
#pragma unroll 4
                    for (int m = 0; m < 256; ++m) { const float v = vp[(size_t)m * 2048];
#pragma unroll
                        for (int q4 = 0; q4 < 4; ++q4) { const f32x4 pr = *(const LAS f32x4*)(Pt + m * 16 + q4 * 4);
                            acc[q4 * 4 + 0] += pr[0] * v; acc[q4 * 4 + 1] += pr[1] * v; acc[q4 * 4 + 2] += pr[2] * v; acc[q4 * 4 + 3] += pr[3] * v; } }
#pragma unroll
                    for (int q = 0; q < 16; ++q) Ob[(size_t)(R0 + q) * D + h * 512 + tid] = (bf16_t)f2bf(acc[q]);
                }
            }
        }
    }
    SEAM(8);
    if (IN(10)) { PHASE_VARS thin_gemm_bf16<1024>(lds, Ob, WxoT, D, T2, c, tid, wid, lane); pg8::GridSched S; S.init(Pb, NT, SEQ, D, 1024, 1024, G, c); pg8::EpiBf16 E{T2, D}; pg8::gemm_phase(lds, S, E, 1024, 1024, 1024, tid); }
    SEAM(10);
    if (IN(11)) { PHASE_VARS
        LAS float* scr = (LAS float*)(lds + wid * 16896);
        constexpr int I_UP = 32 * 176, I_DN = 88 * 32;
        (void)scr; (void)I_UP;
        (void)I_DN;
        for (int m = gw; m < MR; m += NGW)
            row_pass<true, 3>(T2 + (size_t)m * D, X1B + (size_t)m * D, (bf16_t*)(out + (size_t)m * D) + D, p.in[24], p.in[30], U3 + (size_t)m * D, lane);
    }
    SEAM(11);
    if (IN(12)) { PHASE_VARS pg8::GridSched S; S.init(U3, WupT, MP, NUP, D, D, G, c); pg8::EpiBf16 E{UP, NUP}; pg8::gemm_phase(lds, S, E, D, D, D, tid);
        if (c >= 172) {
            __syncthreads();
            LAS float* scr = (LAS float*)(lds + wid * 16896);
            for (int it = (c - 172) * 8 + wid; it < 88 * 32; it += (G - 172) * 8) transpose_item(p.in[35], DFF, D, WdnT, scr, it, lane);
        } }
    SEAM(12);
    if (IN(13)) { PHASE_VARS
        constexpr int NCG = DFF / 8;
        const float* cwp = p.in[33]; const float* cbp = p.in[34];
        for (int w = c * 512 + tid; w < (MR / 16) * NCG; w += G * 512) {
            const int rg = w / NCG, cg = w - rg * NCG, r0 = rg * 16, ch = cg * 8; const bool smp = r0 >= SEQ; const int b = (r0 - SEQ) >> 4;
            float wg[3][8], wv[3][8], bg[8], bv[8], g2[8], g1[8], v2[8], v1[8];
#pragma unroll
            for (int k = 0; k < 3; ++k) { const f32x4 a0 = *(const f32x4*)(cwp + k * NUP + ch), a1 = *(const f32x4*)(cwp + k * NUP + ch + 4), c0 = *(const f32x4*)(cwp + k * NUP + DFF + ch), c1 = *(const f32x4*)(cwp + k * NUP + DFF + ch + 4);
#pragma unroll
                for (int e = 0; e < 4; ++e) { wg[k][e] = a0[e]; wg[k][4 + e] = a1[e]; wv[k][e] = c0[e]; wv[k][4 + e] = c1[e]; } }
            { const f32x4 a0 = *(const f32x4*)(cbp + ch), a1 = *(const f32x4*)(cbp + ch + 4), c0 = *(const f32x4*)(cbp + DFF + ch), c1 = *(const f32x4*)(cbp + DFF + ch + 4);
#pragma unroll
                for (int e = 0; e < 4; ++e) { bg[e] = a0[e]; bg[4 + e] = a1[e]; bv[e] = c0[e]; bv[4 + e] = c1[e]; } }
            if (smp) { const float* s0 = p.in[6] + (size_t)b * 2 * NUP + ch;
#pragma unroll
                for (int e = 0; e < 8; ++e) { g2[e] = s0[e]; v2[e] = s0[DFF + e]; g1[e] = s0[NUP + e]; v1[e] = s0[NUP + DFF + e]; } }
            else if (r0 == 0) {
#pragma unroll
                for (int e = 0; e < 8; ++e) { g2[e] = 0.f; g1[e] = 0.f; v2[e] = 0.f; v1[e] = 0.f; } }
            else { const bf16_t* u2 = UP + (size_t)(r0 - 2) * NUP + ch; const u32x4 a2 = *(const u32x4*)u2, c2 = *(const u32x4*)(u2 + DFF), a1 = *(const u32x4*)(u2 + NUP), c1 = *(const u32x4*)(u2 + NUP + DFF);
#pragma unroll
                for (int e = 0; e < 4; ++e) { g2[2 * e] = bf_lo(a2[e]); g2[2 * e + 1] = bf_hi(a2[e]); v2[2 * e] = bf_lo(c2[e]); v2[2 * e + 1] = bf_hi(c2[e]);
                    g1[2 * e] = bf_lo(a1[e]); g1[2 * e + 1] = bf_hi(a1[e]); v1[2 * e] = bf_lo(c1[e]); v1[2 * e + 1] = bf_hi(c1[e]); } }
#pragma unroll 2
            for (int t = 0; t < 16; ++t) { const bf16_t* u = UP + (size_t)(r0 + t) * NUP + ch; const u32x4 ua = *(const u32x4*)u, uc = *(const u32x4*)(u + DFF);
                float ga[8], va[8], o[8];
#pragma unroll
                for (int e = 0; e < 4; ++e) { ga[2 * e] = bf_lo(ua[e]); ga[2 * e + 1] = bf_hi(ua[e]); va[2 * e] = bf_lo(uc[e]); va[2 * e + 1] = bf_hi(uc[e]); }
#pragma unroll
                for (int e = 0; e < 8; ++e) { const float yg = bg[e] + wg[0][e] * g2[e] + wg[1][e] * g1[e] + wg[2][e] * ga[e], yv = bv[e] + wv[0][e] * v2[e] + wv[1][e] * v1[e] + wv[2][e] * va[e];
                    o[e] = gelu_tanh(yg) * yv; g2[e] = g1[e]; g1[e] = ga[e]; v2[e] = v1[e]; v1[e] = va[e]; }
                u32x4 ow; ow.x = pk2h(o[0], o[1]); ow.y = pk2h(o[2], o[3]); ow.z = pk2h(o[4], o[5]); ow.w = pk2h(o[6], o[7]);
                *(u32x4*)(Gb + (size_t)(r0 + t) * DFF + ch) = ow; }
            if (smp || r0 == SEQ - 16) { float* o = (smp ? out + O_SCF + (size_t)b * 2 * NUP : out + O_PCF) + ch;
#pragma unroll
                for (int e = 0; e < 8; ++e) { o[e] = g2[e]; o[DFF + e] = v2[e]; o[NUP + e] = g1[e]; o[NUP + DFF + e] = v1[e]; } }
        }
    }
    SEAM(13);
    if (IN(14)) { PHASE_VARS thin_gemm_bf16<512>(lds, Gb, WdnT, DFF, T, c, tid, wid, lane); pg8::GridSched S; S.init(Gb, WdnT, SEQ, D, DFF, DFF, G, c); pg8::EpiBf16 E{T, D}; pg8::gemm_phase(lds, S, E, DFF, DFF, DFF, tid); }
    SEAM(14);
    if (IN(15)) { PHASE_VARS
        for (int m = gw; m < MR; m += NGW)
            final_row_pass(T + (size_t)m * D, out + (size_t)m * D, p.in[31], lane);
    }
    if (p.ph_lo < 0) grid.sync();
#undef IN
#undef SEAM
#undef out
#undef WSP
#undef WinT
#undef WkvT
#undef WpaT
#undef WpbT
#undef WoT
#undef WqT
#undef WxoT
#undef WrT
#undef WiT
#undef WupT
#undef WdnT
#undef KB
#undef VB
#undef NT
#undef WqN
#undef MT
#undef RS1
#undef MN
#undef PSP
#undef PSS
#undef FLG
#undef PS2
#undef Z
#undef UP
#undef X1B
#undef T
#undef U
#undef HLOC
#undef MIX
#undef Qb
#undef CP
#undef U2
#undef Ob
#undef HA
#undef Pb
#undef HBb
#undef U3
#undef T2
#undef Gb
#undef PHASE_VARS
}
constexpr int NPH = 16;

extern "C" void kernel_launch(void* const* d_in, const int* in_sizes, int n_in, void* d_out, int out_size, void* d_ws, size_t ws_size, hipStream_t stream) {
    static int grid = 0;
    if (grid == 0) {
        if (n_in != 36 || out_size != 18382848 || ws_size < WS_END + 16777216 + 65536) { fprintf(stderr, "kernel_launch: unexpected shapes: n_in %d out %d ws %zu (need %zu)\n", n_in, out_size, ws_size, (size_t)WS_END); grid = -1; return; }
        int dev = 0, cus = 0, per_cu = 0;
        hipGetDevice(&dev); hipDeviceGetAttribute(&cus, hipDeviceAttributeMultiprocessorCount, dev);
        if (hipFuncSetAttribute((const void*)mega, hipFuncAttributeMaxDynamicSharedMemorySize, LDS_BYTES) != hipSuccess) { fprintf(stderr, "kernel_launch: hipFuncSetAttribute failed\n"); grid = -1; return; }
        hipOccupancyMaxActiveBlocksPerMultiprocessor(&per_cu, (const void*)mega, 512, LDS_BYTES);
        if (per_cu < 1 || cus * per_cu < 256) { fprintf(stderr, "kernel_launch: occupancy %d x %d CUs < 256 workgroups\n", per_cu, cus); grid = -1; return; }
        grid = 256;
    }
    if (grid < 0) return;
    hipMemsetAsync((char*)d_ws + WS_BAR, 0, 32768, stream);
    Params p{};
    for (int i = 0; i < 36; ++i) p.in[i] = (const float*)d_in[i];
    p.out = (float*)d_out; p.ws = (unsigned char*)d_ws;
#if PROBE_PH >= 0
    { const int cuts[4] = {0, PROBE_PH + 1, PROBE_PH, NPH}; const int ends[3] = {PROBE_PH + 1, PROBE_PH + 1, NPH};
      for (int k = 0; k < 3; ++k) { p.ph_lo = (k == 0) ? 0 : (k == 1 ? PROBE_PH : PROBE_PH + 1); p.ph_hi = ends[k]; (void)cuts; void* args[] = {&p};
        if (k > 0) (void)hipMemsetAsync((char*)d_ws + WS_BAR, 0, 32768, stream);
        hipError_t e = hipLaunchCooperativeKernel((const void*)mega, dim3(grid), dim3(512), args, LDS_BYTES, stream);
        if (e != hipSuccess) { fprintf(stderr, "launch %d failed: %s\n", k, hipGetErrorString(e)); break; } } }
#elif N_LAUNCH_MODE == 1
    p.ph_lo = 0; p.ph_hi = NPH;
    { void* args[] = {&p}; hipError_t e = hipLaunchCooperativeKernel((const void*)mega, dim3(grid), dim3(512), args, LDS_BYTES, stream);
      if (e != hipSuccess) fprintf(stderr, "cooperative launch failed: %s\n", hipGetErrorString(e)); }
#else
    for (int k = 0; k < NPH; ++k) { p.ph_lo = k; p.ph_hi = k + 1; void* args[] = {&p};
        hipError_t e = hipLaunchCooperativeKernel((const void*)mega, dim3(grid), dim3(512), args, LDS_BYTES, stream);
        if (e != hipSuccess) { fprintf(stderr, "launch %d failed: %s\n", k, hipGetErrorString(e)); break; } }
#endif
}
```

```cpp
#include <hip/hip_runtime.h>
#include <hip/hip_cooperative_groups.h>
#include <cstdio>
#include <cstdint>
namespace cg = cooperative_groups;

#ifndef N_LAUNCH_MODE
#define N_LAUNCH_MODE 1
#endif
#ifndef PROBE_PH
#define PROBE_PH -1
#endif
#ifndef USE_XCD_BAR
#define USE_XCD_BAR 1
#endif

#define LAS __attribute__((address_space(3)))
typedef unsigned short bf16_t;
typedef short bf16x8 __attribute__((ext_vector_type(8)));
typedef float f32x4 __attribute__((ext_vector_type(4)));
typedef float f32x16 __attribute__((ext_vector_type(16)));
typedef unsigned u32x4 __attribute__((ext_vector_type(4)));
typedef unsigned u32x2 __attribute__((ext_vector_type(2)));

constexpr int D = 2048, SEQ = 8192, MR = 8320, MP = 8448, NIN = 11264, DC = 1024, DFF = 5632, NUP = 11264, NMEM = 256;
constexpr int Z_GA = 2048, Z_GB = 4096, Z_GC = 5120, Z_HB = 6144, Z_GATEA = 7168, Z_GATEB = 9216;
constexpr int NCHUNK = 130;
constexpr float EPS = 1e-6f;
constexpr size_t O_YP = 0, O_PCA = 17039360, O_PRH = 17045504, O_PCB = 17047552, O_PCF = 17049600, O_PMK = 17072128, O_PMV = 17596416,
                 O_SCA = 18120704, O_SRH = 18169856, O_SCB = 18186240, O_SCF = 18202624;
constexpr size_t WS_WKV = 0, WS_WPA = 16777216, WS_WPB = 25165824, WS_WO = 29360128, WS_WQ = 37748736, WS_WXO = 46137344,
                 WS_WR = 54525952, WS_WI = 55050240, WS_KB = 55574528, WS_VT = 56623104, WS_MN = 57671680, WS_PSP = 58720256, WS_PSS = 59785216,
                 WS_BAR = 60850176, WS_Z = 60915712, WS_T = WS_Z + 190316544, WS_B = WS_T + 46137344, WS_END = WS_B + 121110528;
constexpr size_t B1 = WS_B, B2 = WS_B + 34603008, B3 = WS_B + 69206016, B4 = WS_B + 103809024;
constexpr size_t WS_WIN = WS_T, WS_WUP = WS_B, WS_U3 = WS_B + 46137344, WS_G = WS_B, WS_WDN = WS_B + 95158272;
constexpr int LDS_BYTES = 153600;

struct Params { const float* in[36]; float* out; unsigned char* ws; int ph_lo, ph_hi; };

__device__ __forceinline__ unsigned f2bf(float f) { unsigned u = __float_as_uint(f); return (u + 0x7fffu + ((u >> 16) & 1u)) >> 16; }
__device__ __forceinline__ unsigned pk2(float lo, float hi) { return f2bf(lo) | (f2bf(hi) << 16); }
__device__ __forceinline__ unsigned pk2h(float lo, float hi) { unsigned r; asm("v_cvt_pk_bf16_f32 %0, %1, %2" : "=v"(r) : "v"(lo), "v"(hi)); return r; }
__device__ __forceinline__ float bf_lo(unsigned u) { return __uint_as_float(u << 16); }
__device__ __forceinline__ float bf_hi(unsigned u) { return __uint_as_float(u & 0xffff0000u); }
__device__ __forceinline__ float bf1(bf16_t b) { return __uint_as_float(((unsigned)b) << 16); }
__device__ __forceinline__ float wave_sum(float v) {
#pragma unroll
    for (int o = 1; o < 64; o <<= 1) v += __shfl_xor(v, o);
    return v;
}
__device__ __forceinline__ float wave_max(float v) {
#pragma unroll
    for (int o = 1; o < 64; o <<= 1) v = fmaxf(v, __shfl_xor(v, o));
    return v;
}
__device__ __forceinline__ float sigmoidf_(float x) { return __builtin_amdgcn_rcpf(1.0f + __expf(-x)); }
__device__ __forceinline__ float gelu_tanh(float x) { const float u = 1.5957691216057308f * (x + 0.044715f * x * x * x); return x * __builtin_amdgcn_rcpf(1.0f + __expf(-u)); }
#define LDS_WAIT() asm volatile("s_waitcnt lgkmcnt(0)" ::: "memory")
__device__ __forceinline__ int lane_id_() { int l; asm volatile("v_mbcnt_lo_u32_b32 %0, -1, 0\n\tv_mbcnt_hi_u32_b32 %0, -1, %0" : "=v"(l)); return l; }

#define XB_TMO      128
#define XB_XCNT(j)  (256  + 64 * (j))
#define XB_XSUB(j)  (1280 + 64 * (j))
#define XB_XGEN(j)  (2304 + 64 * (j))
#define XB_TOP      3328
#define XB_TOPGEN   3392
#define XCD_BAR_WORDS 3456
#define XB_SPIN_CAP (1u << 22)
__device__ __forceinline__ unsigned xb_ld(unsigned* p)              { return __hip_atomic_load(p, __ATOMIC_RELAXED, __HIP_MEMORY_SCOPE_AGENT); }
__device__ __forceinline__ unsigned xb_add(unsigned* p, unsigned v) { return __hip_atomic_fetch_add(p, v, __ATOMIC_RELAXED, __HIP_MEMORY_SCOPE_AGENT); }
__device__ __forceinline__ unsigned xb_xcc_id() { return (unsigned)__builtin_amdgcn_s_getreg((3 << 11) | 20) & 0xFu; }
#define XB_SPIN(cond, bar) do { unsigned _sp = 0; while (cond) { __builtin_amdgcn_s_sleep(1); \
    if ((++_sp & 255u) == 0u) { if (xb_ld(&(bar)[XB_TMO])) break; if (_sp > XB_SPIN_CAP) { atomicAdd(&(bar)[XB_TMO], 1u); break; } } } } while (0)
struct XcdBarrier { unsigned* bar; unsigned x; volatile LAS unsigned* st; };
__device__ __forceinline__ XcdBarrier xcd_barrier_post(unsigned* bar, volatile LAS unsigned* st) {
    XcdBarrier b; b.bar = bar; b.x = xb_xcc_id(); b.st = st;
    if (threadIdx.x == 0) (void)xb_add(&bar[XB_XCNT(b.x)], 1u);
    return b;
}
__device__ __forceinline__ void xcd_barrier_complete(unsigned* bar, unsigned x, unsigned& nloc, unsigned& nx) {
    const unsigned G = gridDim.x * gridDim.y * gridDim.z;
    unsigned sum, cnt, mine, sp = 0u;
    for (;;) {
        sum = 0u; cnt = 0u; mine = 0u;
#pragma unroll
        for (unsigned j = 0; j < 16; ++j) { const unsigned c = xb_ld(&bar[XB_XCNT(j)]); sum += c; cnt += (c > 0u) ? 1u : 0u; mine = (j == x) ? c : mine; }
        if (sum == G) break;
        __builtin_amdgcn_s_sleep(1);
        if ((++sp & 255u) == 0u) { if (xb_ld(&bar[XB_TMO])) break; if (sp > XB_SPIN_CAP) { atomicAdd(&bar[XB_TMO], 1u); break; } }
    }
    nloc = mine > 0u ? mine : 1u; nx = cnt > 0u ? cnt : 1u;
}
__device__ __forceinline__ void xcd_barrier(const XcdBarrier& b, const bool leader) {
    asm volatile("s_waitcnt vmcnt(0)" ::: "memory");
    __syncthreads();
    if (leader) {
        unsigned* bar = b.bar;
        __builtin_amdgcn_s_waitcnt(0);
        unsigned nloc = b.st[0], nx = b.st[1];
        if (nloc == 0u) { xcd_barrier_complete(bar, b.x, nloc, nx); b.st[0] = nloc; b.st[1] = nx; }
        const unsigned old = xb_add(&bar[XB_XSUB(b.x)], 1u);
        const unsigned gen = old / nloc;
        if (old + 1u == (gen + 1u) * nloc) {
            __builtin_amdgcn_fence(__ATOMIC_RELEASE, "agent");
            asm volatile("s_waitcnt vmcnt(0)" ::: "memory");
            const unsigned og = xb_add(&bar[XB_TOP], 1u);
            const unsigned tg = og / nx;
            if (og + 1u == (tg + 1u) * nx) xb_add(&bar[XB_TOPGEN], 1u);
            else XB_SPIN(xb_ld(&bar[XB_TOPGEN]) == tg, bar);
            __builtin_amdgcn_fence(__ATOMIC_ACQUIRE, "agent");
            xb_add(&bar[XB_XGEN(b.x)], 1u);
            asm volatile("s_waitcnt vmcnt(0)" ::: "memory");
        } else {
            XB_SPIN(xb_ld(&bar[XB_XGEN(b.x)]) == gen, bar);
            __builtin_amdgcn_fence(__ATOMIC_ACQUIRE, "agent");
            asm volatile("s_waitcnt vmcnt(0)" ::: "memory");
        }
    }
    __syncthreads();
}

namespace pg8 {
constexpr int BM = 256, BK = 64, HALF = 128, HTB = HALF * BK * 2, STAGE_BYTES = 8 * HTB, NXCD = 8, WGM = 8;
__host__ __device__ __forceinline__ int lds_byte(int r, int c) { const int st = (r >> 4) * 2 + (c >> 5), rr = r & 15, cc = c & 31, ob = rr * 64 + cc * 2; return st * 1024 + (ob ^ (((ob >> 9) & 1) << 5)); }
__host__ __device__ __forceinline__ void stage_rc(int b, int& R, int& C) { const int st = b / 1024, sb = b % 1024, swz = sb ^ (((sb >> 9) & 1) << 5); R = (st >> 1) * 16 + swz / 64; C = (st & 1) * 32 + (swz % 64) / 2; }
__host__ __device__ __forceinline__ int perm32(int rho) { const int n = rho >> 4, i = rho & 15; return 8 * (i >> 2) + 4 * n + (i & 3); }

struct Unit { int pm, pn, h, col0; };

struct GridSched {
    int nM, nN, nwg, G, c; const char* A; const char* Bt; size_t atile, btile;
    __device__ __forceinline__ void init(const void* A_, const void* Bt_, int M, int N, int lda, int ldb, int G_, int c_) {
        nM = M / BM; nN = N / BM; nwg = nM * nN; G = G_; c = c_; A = (const char*)A_; Bt = (const char*)Bt_; atile = (size_t)BM * lda * 2; btile = (size_t)BM * ldb * 2; }
    __device__ __forceinline__ bool next(int i, Unit& u) const {
        const long L = (long)i * G + c; if (L >= nwg) return false;
        int wgid = (int)L; { const int q = nwg / NXCD, r = nwg % NXCD, xcd = wgid % NXCD, off = wgid / NXCD; wgid = (xcd < r ? xcd * (q + 1) : r * (q + 1) + (xcd - r) * q) + off; }
        const int nig = WGM * nN, gid = wgid / nig, fm = gid * WGM, gsz = (nM - fm) < WGM ? (nM - fm) : WGM;
        u.pm = fm + ((wgid % nig) % gsz); u.pn = (wgid % nig) / gsz; u.h = 0; u.col0 = u.pn * BM; return true;
    }
    __device__ __forceinline__ const char* abase(const Unit& u) const { return A + (size_t)u.pm * atile; }
    __device__ __forceinline__ const char* bbase(const Unit& u) const { return Bt + (size_t)u.pn * btile; }
};
struct AttnSSched {
    int G, c; const char* Q; const char* KB;
    __device__ __forceinline__ bool next(int i, Unit& u) const { const int L = i * G + c; if (L >= 128) return false; const int x = L & 7, j = L >> 3; u.pm = 4 * x + (j >> 2); u.h = j & 3; u.pn = 0; u.col0 = u.h * 256; return true; }
    __device__ __forceinline__ const char* abase(const Unit& u) const { return Q + (size_t)u.pm * 256 * 2048 * 2; }
    __device__ __forceinline__ const char* bbase(const Unit& u) const { return KB + (size_t)u.h * 2048 * 2; }
};
struct MTSched {
    int L; const char* KB_; const char* WqN_;
    __device__ __forceinline__ bool next(int i, Unit& u) const { if (i > 0) return false; u.pm = 0; u.h = L >> 3; u.pn = L & 7; u.col0 = u.h * 2048 + u.pn * 256; return true; }
    __device__ __forceinline__ const char* abase(const Unit& u) const { return KB_ + (size_t)u.h * 512 * 2; }
    __device__ __forceinline__ const char* bbase(const Unit& u) const { return WqN_ + ((size_t)u.pn * 256 * 2048 + u.h * 512) * 2; }
};
struct NTSched {
    int L; const char* WxoT_; const char* VB_;
    __device__ __forceinline__ bool next(int i, Unit& u) const { if (i > 0) return false; u.pm = L & 7; u.h = L >> 3; u.pn = 0; u.col0 = u.h * 256; return true; }
    __device__ __forceinline__ const char* abase(const Unit& u) const { return WxoT_ + ((size_t)u.pm * 256 * 2048 + u.h * 512) * 2; }
    __device__ __forceinline__ const char* bbase(const Unit& u) const { return VB_ + (size_t)u.h * 512 * 2; }
};

struct EpiBf16 {
    static constexpr bool PERM = true, AFTER_DRAIN = false;
    bf16_t* O; int ldc;
    __device__ __forceinline__ void operator()(const f32x4 (&acc)[2][2][4][2], const Unit& u, int wr, int wc, int fr, int fq) const {
        const int row0 = u.pm * BM + wr * 64 + fr; const int col0 = u.col0 + wc * 32 + 8 * fq;
#pragma unroll
        for (int ai = 0; ai < 2; ++ai)
#pragma unroll
            for (int m = 0; m < 4; ++m) { bf16_t* rowp = O + (size_t)(row0 + ai * HALF + m * 16) * ldc + col0;
#pragma unroll
                for (int bj = 0; bj < 2; ++bj) { const f32x4 v0 = acc[ai][bj][m][0], v1 = acc[ai][bj][m][1];
                    u32x4 w; w.x = pk2(v0[0], v0[1]); w.y = pk2(v0[2], v0[3]); w.z = pk2(v1[0], v1[1]); w.w = pk2(v1[2], v1[3]);
                    *(u32x4*)(rowp + bj * HALF) = w; } }
    }
};
struct EpiKV {
    static constexpr bool PERM = false, AFTER_DRAIN = false;
    float* outk; float* outv; bf16_t* KB; bf16_t* VB;
    __device__ __forceinline__ void operator()(const f32x4 (&acc)[2][2][4][2], const Unit& u, int wr, int wc, int fr, int fq) const {
        const int row0 = u.pm * BM + wr * 64 + fr; const bool isk = u.pn < 8; const int col0 = (isk ? u.col0 : u.col0 - 2048) + wc * 32 + 4 * fq;
        float* ob = isk ? outk : outv;
#pragma unroll
        for (int ai = 0; ai < 2; ++ai)
#pragma unroll
            for (int m = 0; m < 4; ++m) { const size_t ro = (size_t)(row0 + ai * HALF + m * 16) * 2048 + col0;
#pragma unroll
                for (int bj = 0; bj < 2; ++bj)
#pragma unroll
                    for (int n = 0; n < 2; ++n) { const f32x4 v = acc[ai][bj][m][n]; *(f32x4*)(ob + ro + bj * HALF + n * 16) = v;
                        { u32x2 w; w.x = pk2(v[0], v[1]); w.y = pk2(v[2], v[3]); *(u32x2*)((isk ? KB : VB) + ro + bj * HALF + n * 16) = w; } } }
    }
};
struct EpiMix {
    static constexpr bool PERM = true, AFTER_DRAIN = false;
    const bf16_t* Z; bf16_t* MIX; int SECOND;
    __device__ __forceinline__ void operator()(const f32x4 (&acc)[2][2][4][2], const Unit& u, int wr, int wc, int fr, int fq) const {
        const int row0 = u.pm * BM + wr * 64 + fr; const int col0 = u.col0 + wc * 32 + 8 * fq;
#pragma unroll
        for (int ai = 0; ai < 2; ++ai) {
            u32x4 g[4][2], o[4][2];
#pragma unroll
            for (int m = 0; m < 4; ++m)
#pragma unroll
                for (int bj = 0; bj < 2; ++bj) { const int row = row0 + ai * HALF + m * 16;
                    g[m][bj] = *(const u32x4*)(Z + (size_t)row * NIN + (SECOND ? Z_GATEB : Z_GATEA) + col0 + bj * HALF);
                    if (SECOND) o[m][bj] = *(const u32x4*)(MIX + (size_t)row * D + col0 + bj * HALF); }
#pragma unroll
            for (int m = 0; m < 4; ++m)
#pragma unroll
                for (int bj = 0; bj < 2; ++bj) { const int row = row0 + ai * HALF + m * 16; const f32x4 a0 = acc[ai][bj][m][0], a1 = acc[ai][bj][m][1]; const u32x4 gg = g[m][bj];
                    float v[8];
                    v[0] = sigmoidf_(bf_lo(gg.x)) * a0[0]; v[1] = sigmoidf_(bf_hi(gg.x)) * a0[1]; v[2] = sigmoidf_(bf_lo(gg.y)) * a0[2]; v[3] = sigmoidf_(bf_hi(gg.y)) * a0[3];
                    v[4] = sigmoidf_(bf_lo(gg.z)) * a1[0]; v[5] = sigmoidf_(bf_hi(gg.z)) * a1[1]; v[6] = sigmoidf_(bf_lo(gg.w)) * a1[2]; v[7] = sigmoidf_(bf_hi(gg.w)) * a1[3];
                    if (SECOND) { const u32x4 oo = o[m][bj]; v[0] += bf_lo(oo.x); v[1] += bf_hi(oo.x); v[2] += bf_lo(oo.y); v[3] += bf_hi(oo.y); v[4] += bf_lo(oo.z); v[5] += bf_hi(oo.z); v[6] += bf_lo(oo.w); v[7] += bf_hi(oo.w); }
                    u32x4 w; w.x = pk2(v[0], v[1]); w.y = pk2(v[2], v[3]); w.z = pk2(v[4], v[5]); w.w = pk2(v[6], v[7]);
                    *(u32x4*)(MIX + (size_t)row * D + col0 + bj * HALF) = w; }
        }
    }
};
struct EpiSoftmax {
    static constexpr bool PERM = false, AFTER_DRAIN = true;
    bf16_t* P; int ldc; float sc; const float* rs;
    __device__ __forceinline__ void fused(f32x4 (&acc)[2][2][4][2], const Unit& u, int wr, int wc, int fr, int fq, LAS unsigned char* lds, int wid, int lane) const {
        LAS float* TM = (LAS float*)lds; LAS float* TS = (LAS float*)(lds + 4096);
#pragma unroll
        for (int ai = 0; ai < 2; ++ai)
#pragma unroll
            for (int m = 0; m < 4; ++m) { float mx = -3.0e38f; const float scr_ = sc * rs[u.pm * BM + ai * HALF + wr * 64 + m * 16 + fr];
#pragma unroll
                for (int bj = 0; bj < 2; ++bj)
#pragma unroll
                    for (int n = 0; n < 2; ++n) { f32x4 v = acc[ai][bj][m][n] * scr_; acc[ai][bj][m][n] = v; mx = fmaxf(mx, fmaxf(fmaxf(v[0], v[1]), fmaxf(v[2], v[3]))); }
                mx = fmaxf(mx, __shfl_xor(mx, 16)); mx = fmaxf(mx, __shfl_xor(mx, 32));
                if (fq == 0) TM[(ai * HALF + wr * 64 + m * 16 + fr) * 4 + wc] = mx; }
        LDS_WAIT(); __builtin_amdgcn_s_barrier(); asm volatile("" ::: "memory");
#pragma unroll
        for (int ai = 0; ai < 2; ++ai)
#pragma unroll
            for (int m = 0; m < 4; ++m) { const int r = ai * HALF + wr * 64 + m * 16 + fr; const f32x4 t = *(const LAS f32x4*)(TM + r * 4);
                const float mx = fmaxf(fmaxf(t[0], t[1]), fmaxf(t[2], t[3])); float s = 0.f;
#pragma unroll
                for (int bj = 0; bj < 2; ++bj)
#pragma unroll
                    for (int n = 0; n < 2; ++n) { f32x4 v = acc[ai][bj][m][n];
                        v[0] = __builtin_amdgcn_exp2f(v[0] - mx); v[1] = __builtin_amdgcn_exp2f(v[1] - mx); v[2] = __builtin_amdgcn_exp2f(v[2] - mx); v[3] = __builtin_amdgcn_exp2f(v[3] - mx);
                        acc[ai][bj][m][n] = v; s += (v[0] + v[1]) + (v[2] + v[3]); }
                s += __shfl_xor(s, 16); s += __shfl_xor(s, 32);
                if (fq == 0) TS[r * 4 + wc] = s; }
        LDS_WAIT(); __builtin_amdgcn_s_barrier(); asm volatile("" ::: "memory");
#pragma unroll
        for (int ai = 0; ai < 2; ++ai)
#pragma unroll
            for (int m = 0; m < 4; ++m) { const int r = ai * HALF + wr * 64 + m * 16 + fr; const f32x4 t = *(const LAS f32x4*)(TS + r * 4);
                const float inv = 1.0f / ((t[0] + t[1]) + (t[2] + t[3]));
                bf16_t* rowp = P + (size_t)(u.pm * BM + r) * ldc + u.col0 + wc * 32 + 4 * fq;
#pragma unroll
                for (int bj = 0; bj < 2; ++bj)
#pragma unroll
                    for (int n = 0; n < 2; ++n) { const f32x4 v = acc[ai][bj][m][n] * inv; u32x2 w; w.x = pk2(v[0], v[1]); w.y = pk2(v[2], v[3]); *(u32x2*)(rowp + bj * HALF + n * 16) = w; } }
    }
};

template <class Epi, class Sched>
__device__ __forceinline__ void gemm_phase(LAS unsigned char* lds, const Sched& S, const Epi& E, const int K, const int lda, const int ldb, const int tid) {
    constexpr bool ALIGN_EPI = !Epi::AFTER_DRAIN;
    const int wid = __builtin_amdgcn_readfirstlane(tid >> 6), lane = tid & 63, wr = wid >> 2, wc = wid & 3, fr = lane & 15, fq = lane >> 4;
    const int nt = K / BK;
    unsigned voffA[2], voffB[2];
#pragma unroll
    for (int i = 0; i < 2; ++i) { int R, C; stage_rc(tid * 16 + i * 8192, R, C); const int Rb = Epi::PERM ? ((R & ~31) + perm32(R & 31)) : R;
        voffA[i] = (unsigned)(R * lda + C) * 2u; voffB[i] = (unsigned)(Rb * ldb + C) * 2u; }
    const size_t kstep = (size_t)(BK * 2);
    const size_t hstepA = (size_t)HALF * lda * 2, hstepB = (size_t)HALF * ldb * 2;
    const unsigned ldsw = (unsigned)wid * 1024u;
    const int aoff = lds_byte(wr * 64 + fr, fq * 8), boff = lds_byte(wc * 32 + fr, fq * 8);
#define PG8_SA(b, h) (((b) * 2 + (h)) * HTB)
#define PG8_SB(b, h) ((4 + (b) * 2 + (h)) * HTB)
#define PG8_STAGE(bufoff, gbase, voff) do { _Pragma("unroll") for (int _i = 0; _i < 2; ++_i) \
        __builtin_amdgcn_global_load_lds((const unsigned*)((const char*)(gbase) + (voff)[_i]), (LAS unsigned*)(lds + (bufoff) + ldsw + _i * 8192), 16, 0, 0); } while (0)
#define PG8_LDA(dst, b, h) do { _Pragma("unroll") for (int m = 0; m < 4; ++m) _Pragma("unroll") for (int k = 0; k < 2; ++k) dst[m][k] = *(const LAS bf16x8*)(lds + PG8_SA(b, h) + aoff + m * 2048 + k * 1024); } while (0)
#define PG8_LDB(dst, b, h) do { _Pragma("unroll") for (int n = 0; n < 2; ++n) _Pragma("unroll") for (int k = 0; k < 2; ++k) dst[n][k] = *(const LAS bf16x8*)(lds + PG8_SB(b, h) + boff + n * 2048 + k * 1024); } while (0)
#define PG8_MMA(ai, bj, At, Bt) do { __builtin_amdgcn_s_setprio(1); _Pragma("unroll") for (int m = 0; m < 4; ++m) _Pragma("unroll") for (int n = 0; n < 2; ++n) _Pragma("unroll") for (int k = 0; k < 2; ++k) \
        acc[ai][bj][m][n] = __builtin_amdgcn_mfma_f32_16x16x32_bf16(Bt[n][k], At[m][k], acc[ai][bj][m][n], 0, 0, 0); __builtin_amdgcn_s_setprio(0); } while (0)
#define PG8_WAIT_V(n) asm volatile("s_waitcnt vmcnt(" #n ")" ::: "memory")
#define PG8_WAIT_L(n) asm volatile("s_waitcnt lgkmcnt(" #n ")" ::: "memory")
#define PG8_BAR __builtin_amdgcn_s_barrier()
#define PG8_SCHED __builtin_amdgcn_sched_barrier(0)
    Unit cur, nxt; int ui = 0;
    if (!S.next(0, cur)) return;
    f32x4 acc[2][2][4][2];
#pragma unroll
    for (int a = 0; a < 2; ++a)
#pragma unroll
        for (int b = 0; b < 2; ++b)
#pragma unroll
            for (int m = 0; m < 4; ++m)
#pragma unroll
                for (int n = 0; n < 2; ++n) acc[a][b][m][n] = (f32x4){0.f, 0.f, 0.f, 0.f};
    bf16x8 At[4][2], B0[2][2], B1[2][2];
    const char* cA = S.abase(cur); const char* cB = S.bbase(cur);
    PG8_STAGE(PG8_SB(0, 0), cB, voffB); PG8_STAGE(PG8_SB(0, 1), cB + hstepB, voffB); PG8_STAGE(PG8_SA(0, 0), cA, voffA); PG8_STAGE(PG8_SA(0, 1), cA + hstepA, voffA);
    if (wr == 1) PG8_BAR;
    PG8_WAIT_V(2); PG8_BAR;
    PG8_STAGE(PG8_SB(1, 0), cB + kstep, voffB); PG8_STAGE(PG8_SA(1, 0), cA + kstep, voffA); PG8_STAGE(PG8_SB(1, 1), cB + hstepB + kstep, voffB);
    PG8_WAIT_V(6); PG8_BAR;
    for (;;) {
        const bool has_next = S.next(ui + 1, nxt);
        const char* nA = has_next ? S.abase(nxt) : cA; const char* nB = has_next ? S.bbase(nxt) : cB;
        for (int t = 0; t < nt; t += 2) {
            const bool last = (t == nt - 2);
            const char* a1 = cA + (size_t)(t + 1) * kstep;
            const char* a2 = last ? nA : cA + (size_t)(t + 2) * kstep; const char* b2 = last ? nB : cB + (size_t)(t + 2) * kstep;
            const char* a3 = a2 + kstep; const char* b3 = b2 + kstep;
            PG8_LDB(B0, 0, 0); PG8_LDB(B1, 0, 1); PG8_SCHED; PG8_LDA(At, 0, 0); PG8_STAGE(PG8_SA(1, 1), a1 + hstepA, voffA);
            PG8_WAIT_V(8); PG8_WAIT_L(0); PG8_BAR; PG8_MMA(0, 0, At, B0); PG8_MMA(0, 1, At, B1); PG8_BAR; PG8_SCHED;
            PG8_LDA(At, 0, 1); PG8_STAGE(PG8_SB(0, 0), b2, voffB); PG8_STAGE(PG8_SB(0, 1), b2 + hstepB, voffB); PG8_STAGE(PG8_SA(0, 0), a2, voffA);
            PG8_WAIT_V(8); PG8_WAIT_L(0); PG8_BAR; PG8_MMA(1, 0, At, B0); PG8_MMA(1, 1, At, B1); PG8_BAR; PG8_SCHED;
            PG8_LDB(B0, 1, 0); PG8_LDB(B1, 1, 1); PG8_SCHED; PG8_LDA(At, 1, 0); PG8_STAGE(PG8_SA(0, 1), a2 + hstepA, voffA);
            PG8_WAIT_V(8); PG8_WAIT_L(0); PG8_BAR; PG8_MMA(0, 0, At, B0); PG8_MMA(0, 1, At, B1); PG8_BAR; PG8_SCHED;
            PG8_LDA(At, 1, 1); PG8_STAGE(PG8_SB(1, 0), b3, voffB); PG8_STAGE(PG8_SB(1, 1), b3 + hstepB, voffB); PG8_STAGE(PG8_SA(1, 0), a3, voffA);
            PG8_WAIT_V(8); PG8_WAIT_L(0); PG8_BAR; PG8_MMA(1, 0, At, B0); PG8_MMA(1, 1, At, B1); PG8_BAR; PG8_SCHED;
        }
        if constexpr (ALIGN_EPI) { if (wr == 0) PG8_BAR; }
        if constexpr (!Epi::AFTER_DRAIN) { E(acc, cur, wr, wc, fr, fq); }
        if (!has_next) break;
#pragma unroll
        for (int a = 0; a < 2; ++a)
#pragma unroll
            for (int b = 0; b < 2; ++b)
#pragma unroll
                for (int m = 0; m < 4; ++m)
#pragma unroll
                    for (int n = 0; n < 2; ++n) acc[a][b][m][n] = (f32x4){0.f, 0.f, 0.f, 0.f};
        cur = nxt; cA = nA; cB = nB; ++ui;
        if constexpr (ALIGN_EPI) { if (wr == 1) PG8_BAR; }
    }
    PG8_WAIT_V(0);
    if constexpr (!ALIGN_EPI) { if (wr == 0) PG8_BAR; }
    PG8_BAR;
    if constexpr (Epi::AFTER_DRAIN) { E.fused(acc, cur, wr, wc, fr, fq, lds, wid, lane); }
#undef PG8_SA
#undef PG8_SB
#undef PG8_STAGE
#undef PG8_LDA
#undef PG8_LDB
#undef PG8_MMA
#undef PG8_WAIT_V
#undef PG8_WAIT_L
#undef PG8_BAR
#undef PG8_SCHED
}
}

__device__ __forceinline__ void transpose_item(const float* W, int K, int N, bf16_t* WT, LAS float* scr, int item, int lane) {
    const int nblk = N / 64, kb = item / nblk, nb = item % nblk, k0 = 64 * kb, n0 = 64 * nb;
    f32x4 v[16];
#pragma unroll
    for (int i = 0; i < 16; ++i) v[i] = __builtin_nontemporal_load((const f32x4*)(W + (size_t)(k0 + 4 * i + (lane >> 4)) * N + n0 + 4 * (lane & 15)));
#pragma unroll
    for (int i = 0; i < 16; ++i) { LAS float* d = scr + (4 * i + (lane >> 4)) * 65 + 4 * (lane & 15); d[0] = v[i][0]; d[1] = v[i][1]; d[2] = v[i][2]; d[3] = v[i][3]; }
    LDS_WAIT(); asm volatile("" ::: "memory");
    const int c = lane & 7;
#pragma unroll
    for (int j = 0; j < 8; ++j) { const int n = (lane >> 3) + 8 * j; const LAS float* s = scr + (8 * c) * 65 + n;
        u32x4 o; o.x = pk2h(s[0 * 65], s[1 * 65]); o.y = pk2h(s[2 * 65], s[3 * 65]); o.z = pk2h(s[4 * 65], s[5 * 65]); o.w = pk2h(s[6 * 65], s[7 * 65]);
        *(u32x4*)(WT + (size_t)(n0 + n) * K + k0 + 8 * c) = o; }
    LDS_WAIT(); asm volatile("" ::: "memory");
}
__device__ __forceinline__ void rms_row_bf16(const float* xrow, const float* g, bf16_t* urow, int lane) {
    f32x4 v[8]; float ss = 0.f;
#pragma unroll
    for (int j = 0; j < 4; ++j) { v[2 * j] = *(const f32x4*)(xrow + j * 512 + lane * 8); v[2 * j + 1] = *(const f32x4*)(xrow + j * 512 + lane * 8 + 4); }
#pragma unroll
    for (int j = 0; j < 8; ++j) ss += (v[j][0] * v[j][0] + v[j][1] * v[j][1]) + (v[j][2] * v[j][2] + v[j][3] * v[j][3]);
    const float r = rsqrtf(wave_sum(ss) * (1.0f / D) + EPS);
#pragma unroll
    for (int j = 0; j < 4; ++j) { const f32x4 g0 = *(const f32x4*)(g + j * 512 + lane * 8), g1 = *(const f32x4*)(g + j * 512 + lane * 8 + 4); const f32x4 a = v[2 * j] * r * g0, b = v[2 * j + 1] * r * g1;
        u32x4 w; w.x = pk2h(a[0], a[1]); w.y = pk2h(a[2], a[3]); w.z = pk2h(b[0], b[1]); w.w = pk2h(b[2], b[3]); *(u32x4*)(urow + j * 512 + lane * 8) = w; }
}
template <bool SECOND, int XMODE, int UMODE = 0>
__device__ __forceinline__ void row_pass(const bf16_t* trow, const void* xrow_, void* orow_, const float* gpost, const float* gpre, bf16_t* urow, int lane, float* rsout = nullptr) {
    f32x4 t[8], xv[8]; float ss = 0.f;
    u32x4 tw_[4];
#pragma unroll
    for (int j = 0; j < 4; ++j) tw_[j] = *(const u32x4*)(trow + j * 512 + lane * 8);
#pragma unroll
    for (int jj = 0; jj < 4; ++jj) { const int off = jj * 512 + lane * 8;
        if (XMODE & 2) { const u32x4 w = *(const u32x4*)((const bf16_t*)xrow_ + off); xv[2 * jj] = (f32x4){bf_lo(w.x), bf_hi(w.x), bf_lo(w.y), bf_hi(w.y)}; xv[2 * jj + 1] = (f32x4){bf_lo(w.z), bf_hi(w.z), bf_lo(w.w), bf_hi(w.w)}; }
        else { xv[2 * jj] = *(const f32x4*)((const float*)xrow_ + off); xv[2 * jj + 1] = *(const f32x4*)((const float*)xrow_ + off + 4); } }
#pragma unroll
    for (int j = 0; j < 4; ++j) { const u32x4 w = tw_[j];
        t[2 * j] = (f32x4){bf_lo(w.x), bf_hi(w.x), bf_lo(w.y), bf_hi(w.y)}; t[2 * j + 1] = (f32x4){bf_lo(w.z), bf_hi(w.z), bf_lo(w.w), bf_hi(w.w)}; }
#pragma unroll
    for (int j = 0; j < 8; ++j) ss += (t[j][0] * t[j][0] + t[j][1] * t[j][1]) + (t[j][2] * t[j][2] + t[j][3] * t[j][3]);
    const float r = rsqrtf(wave_sum(ss) * (1.0f / D) + EPS);
    float ss2 = 0.f;
#pragma unroll
    for (int jj = 0; jj < 4; ++jj) { const int off = jj * 512 + lane * 8; const f32x4 x0 = xv[2 * jj], x1 = xv[2 * jj + 1];
        const f32x4 g0 = *(const f32x4*)(gpost + off), g1 = *(const f32x4*)(gpost + off + 4);
        const f32x4 a = x0 + t[2 * jj] * r * g0, b = x1 + t[2 * jj + 1] * r * g1; t[2 * jj] = a; t[2 * jj + 1] = b;
        if (XMODE & 1) { u32x4 w; w.x = pk2h(a[0], a[1]); w.y = pk2h(a[2], a[3]); w.z = pk2h(b[0], b[1]); w.w = pk2h(b[2], b[3]); *(u32x4*)((bf16_t*)orow_ + off) = w; }
        else { *(f32x4*)((float*)orow_ + off) = a; *(f32x4*)((float*)orow_ + off + 4) = b; }
        ss2 += (a[0] * a[0] + a[1] * a[1]) + (a[2] * a[2] + a[3] * a[3]) + (b[0] * b[0] + b[1] * b[1]) + (b[2] * b[2] + b[3] * b[3]); }
    if (SECOND) {
        const float r2 = rsqrtf(wave_sum(ss2) * (1.0f / D) + EPS);
        if (UMODE == 1) { if (lane == 0) *rsout = r2; return; }
#pragma unroll
        for (int j = 0; j < 4; ++j) { const f32x4 g0 = *(const f32x4*)(gpre + j * 512 + lane * 8), g1 = *(const f32x4*)(gpre + j * 512 + lane * 8 + 4); const f32x4 a = t[2 * j] * r2 * g0, b = t[2 * j + 1] * r2 * g1;
            u32x4 w; w.x = pk2h(a[0], a[1]); w.y = pk2h(a[2], a[3]); w.z = pk2h(b[0], b[1]); w.w = pk2h(b[2], b[3]); *(u32x4*)(urow + j * 512 + lane * 8) = w; }
    }
}


template <int NR>
__device__ __forceinline__ void final_row_pass(const bf16_t* const (&trow)[NR], float* const (&slot)[NR], const float* gpost, int lane) {
    u32x4 tw[NR][4], xw[NR][4];
#pragma unroll
    for (int q = 0; q < NR; ++q)
#pragma unroll
        for (int j = 0; j < 4; ++j) { tw[q][j] = *(const u32x4*)(trow[q] + j * 512 + lane * 8); xw[q][j] = *(const u32x4*)((const bf16_t*)slot[q] + D + j * 512 + lane * 8); }
    asm volatile("s_waitcnt vmcnt(0)" ::: "memory");
#pragma unroll
    for (int q = 0; q < NR; ++q) {
        float ss = 0.f;
#pragma unroll
        for (int j = 0; j < 4; ++j) { const u32x4 w = tw[q][j]; const float a0 = bf_lo(w.x), a1 = bf_hi(w.x), a2 = bf_lo(w.y), a3 = bf_hi(w.y), a4 = bf_lo(w.z), a5 = bf_hi(w.z), a6 = bf_lo(w.w), a7 = bf_hi(w.w);
            ss += (a0 * a0 + a1 * a1) + (a2 * a2 + a3 * a3) + (a4 * a4 + a5 * a5) + (a6 * a6 + a7 * a7); }
        const float r = rsqrtf(wave_sum(ss) * (1.0f / D) + EPS);
#pragma unroll
        for (int j = 0; j < 4; ++j) { const int off = j * 512 + lane * 8; const u32x4 w = tw[q][j], x = xw[q][j];
            const f32x4 g0 = *(const f32x4*)(gpost + off), g1 = *(const f32x4*)(gpost + off + 4);
            const f32x4 t0 = (f32x4){bf_lo(w.x), bf_hi(w.x), bf_lo(w.y), bf_hi(w.y)}, t1 = (f32x4){bf_lo(w.z), bf_hi(w.z), bf_lo(w.w), bf_hi(w.w)};
            const f32x4 x0 = (f32x4){bf_lo(x.x), bf_hi(x.x), bf_lo(x.y), bf_hi(x.y)}, x1 = (f32x4){bf_lo(x.z), bf_hi(x.z), bf_lo(x.w), bf_hi(x.w)};
            *(f32x4*)(slot[q] + off) = x0 + t0 * r * g0; *(f32x4*)(slot[q] + off + 4) = x1 + t1 * r * g1; }
    }
}

template <int KC>
__device__ __forceinline__ f32x16 thin_mac_lds(LAS unsigned char* lds, const bf16_t* A, const bf16_t* Bt, int K, int tid, int wid, int lane) {
    constexpr int NP = KC / 128, SH = (KC == 1024) ? 7 : 6, RS = 2 * KC + 16;
    LAS unsigned char* LA = lds; LAS unsigned char* LB = lds + 32 * RS;
    const int r = lane & 31, hh = lane >> 5;
    f32x16 acc;
#pragma unroll
    for (int e = 0; e < 16; ++e) acc[e] = 0.f;
    u32x4 ra[NP], rb[NP];
    const int prow = tid >> SH, pc8 = tid & ((1 << SH) - 1);
    const bf16_t* ga = A + (size_t)prow * K + pc8 * 8; const bf16_t* gb = Bt + (size_t)prow * K + pc8 * 8;
    const size_t gstep = (size_t)(512 >> SH) * K;
#pragma unroll
    for (int i = 0; i < NP; ++i) { ra[i] = *(const u32x4*)(ga + i * gstep); rb[i] = *(const u32x4*)(gb + i * gstep); }
    for (int k0 = 0; k0 < K; k0 += KC) {
        __syncthreads();
#pragma unroll
        for (int i = 0; i < NP; ++i) { const int row = prow + i * (512 >> SH); *(LAS u32x4*)(LA + row * RS + pc8 * 16) = ra[i]; *(LAS u32x4*)(LB + row * RS + pc8 * 16) = rb[i]; }
        __syncthreads();
        if (k0 + KC < K) {
#pragma unroll
            for (int i = 0; i < NP; ++i) { ra[i] = *(const u32x4*)(ga + i * gstep + k0 + KC); rb[i] = *(const u32x4*)(gb + i * gstep + k0 + KC); } }
        const int ks = wid * (KC / 8);
#pragma unroll
        for (int s2 = 0; s2 < KC / 128; ++s2) { const bf16x8 a = *(const LAS bf16x8*)(LA + r * RS + (ks + 16 * s2 + 8 * hh) * 2), b = *(const LAS bf16x8*)(LB + r * RS + (ks + 16 * s2 + 8 * hh) * 2);
            acc = __builtin_amdgcn_mfma_f32_32x32x16_bf16(a, b, acc, 0, 0, 0); }
    }
    return acc;
}
__device__ __forceinline__ void thin_put(LAS float* red, const f32x16& acc, int wid, int lane) {
    const int col = lane & 31, hh = lane >> 5;
#pragma unroll
    for (int e = 0; e < 16; ++e) red[wid * 1024 + ((e & 3) + 8 * (e >> 2) + 4 * hh) * 32 + col] = acc[e];
}
__device__ __forceinline__ void thin_get(const LAS float* red, int tid, float& v0, float& v1) {
    const int o = (tid >> 4) * 32 + (tid & 15) * 2; v0 = 0.f; v1 = 0.f;
#pragma unroll
    for (int w = 0; w < 8; ++w) { v0 += red[w * 1024 + o]; v1 += red[w * 1024 + o + 1]; }
}
template <int KC>
__device__ __forceinline__ void thin_gemm_bf16(LAS unsigned char* lds, const bf16_t* A, const bf16_t* Bt, int K, bf16_t* O, int c, int tid, int wid, int lane) {
    const int r0 = SEQ + 32 * ((c >> 3) & 3), c0 = 32 * (8 * (c & 7) + (c >> 5)), kw = K / 8;
    LAS float* red = (LAS float*)lds;
    const f32x16 acc = thin_mac_lds<KC>(lds, A + (size_t)r0 * K, Bt + (size_t)c0 * K, K, tid, wid, lane); (void)kw;
    __syncthreads();
    thin_put(red, acc, wid, lane);
    __syncthreads();
    float v0, v1; thin_get(red, tid, v0, v1);
    *(unsigned*)(O + (size_t)(r0 + (tid >> 4)) * D + c0 + (tid & 15) * 2) = pk2(v0, v1);
    __syncthreads();
}

__global__ void __launch_bounds__(512, 2) mega(Params p) {
    extern __shared__ __attribute__((aligned(16))) unsigned char lds_raw[];
    LAS unsigned char* lds = (LAS unsigned char*)lds_raw;
    cg::grid_group grid = cg::this_grid();
    const int wid0_ = __builtin_amdgcn_readfirstlane((int)(threadIdx.x >> 6));
#define IN(k) (p.ph_lo <= (k) && (k) < p.ph_hi)
#define PHASE_VARS int tid = (wid0_ << 6) | lane_id_(); asm volatile("" : "+v"(tid)); const int lane = tid & 63, wid = __builtin_amdgcn_readfirstlane(tid >> 6), c = blockIdx.x, G = gridDim.x; const int gw = c * 8 + wid, NGW = G * 8; (void)lane; (void)gw; (void)NGW;
#if USE_XCD_BAR
    volatile LAS unsigned* bst = (volatile LAS unsigned*)(lds + LDS_BYTES - 16);
    if (threadIdx.x < 4) bst[threadIdx.x] = 0u;
    __syncthreads();
    XcdBarrier xbar = xcd_barrier_post((unsigned*)(p.ws + WS_BAR), bst);
#define SEAM(k) do { if (IN(k) && IN((k) + 1)) { xcd_barrier(xbar, ((wid0_ << 6) | lane_id_()) == 0); } } while (0)
#else
#define SEAM(k) do { if (IN(k) && IN((k) + 1)) grid.sync(); } while (0)
#endif
#define out (p.out)
#define WSP(off) ((bf16_t*)(p.ws + (off)))
#define WinT WSP(WS_WIN)
#define WkvT WSP(WS_WKV)
#define WpaT WSP(WS_WPA)
#define WpbT WSP(WS_WPB)
#define WoT WSP(WS_WO)
#define WqT WSP(WS_WQ)
#define WxoT WSP(WS_WXO)
#define WrT WSP(WS_WR)
#define WiT WSP(WS_WI)
#define WupT WSP(WS_T)
#define WdnT WSP(WS_WDN)
#define KB WSP(WS_KB)
#define VB WSP(WS_VT)
#define NT WSP(WS_END)
#define WqN WSP(WS_END + 4194304)
#define MT WSP(WS_END + 12582912)
#define RS1 ((float*)(p.ws + WS_END + 16777216))
#define MN WSP(WS_MN)
#define PSP ((float*)(p.ws + WS_PSP))
#define PSS ((float*)(p.ws + WS_PSS))
#define PS2 ((unsigned long long*)(p.ws + WS_PSP))
#define FLG ((unsigned*)(p.ws + WS_BAR + 16384))
#define Z WSP(WS_Z)
#define UP WSP(WS_Z)
#define X1B WSP(WS_Z)
#define T WSP(WS_T)
#define U WSP(B1)
#define HLOC WSP(B1)
#define MIX WSP(B1)
#define Qb WSP(B1)
#define CP WSP(B2)
#define U2 WSP(B2)
#define Ob WSP(B2)
#define HA WSP(B3)
#define Pb WSP(B3)
#define HBb WSP(B4)
#define U3 WSP(B1)
#define T2 WSP(B3)
#define Gb WSP(WS_G)
    if (IN(0)) { PHASE_VARS
        LAS float* scr = (LAS float*)(lds + wid * 16896);
        constexpr int I_IN = 32 * 176, I_SQ = 32 * 32, I_PB = 16 * 32, I_BD = 64;
        constexpr int NIT = I_IN + 2 * I_SQ + 2 * I_BD;
        for (int it = gw; it < NIT; it += NGW) {
            int r = it;
            if (r < I_IN) { transpose_item(p.in[11], D, NIN, WinT, scr, r, lane); continue; } r -= I_IN;
            if (r < I_SQ) { transpose_item(p.in[27], D, D, WkvT, scr, r, lane); continue; } r -= I_SQ;
            if (r < I_SQ) { transpose_item(p.in[28], D, D, WkvT + (size_t)D * D, scr, r, lane); continue; } r -= I_SQ;
            if (r < I_BD) { const int hh = r >> 2; transpose_item(p.in[14] + hh * 16384, 128, 128, WrT + hh * 16384, scr, r & 3, lane); continue; } r -= I_BD;
            { const int hh = r >> 2; transpose_item(p.in[16] + hh * 16384, 128, 128, WiT + hh * 16384, scr, r & 3, lane); }
        }
        for (int m = gw; m < MP + NMEM; m += NGW) {
            if (m < SEQ) rms_row_bf16(p.in[0] + (size_t)m * D, p.in[9], U + (size_t)m * D, lane);
            else if (m < MR) rms_row_bf16(p.in[1] + (size_t)(m - SEQ) * D, p.in[9], U + (size_t)m * D, lane);
            else if (m < MP) {
#pragma unroll
                for (int j = 0; j < 4; ++j) *(u32x4*)(U + (size_t)m * D + j * 512 + lane * 8) = (u32x4){0u, 0u, 0u, 0u}; }
            else rms_row_bf16(p.in[2] + (size_t)(m - MP) * D, p.in[25], MN + (size_t)(m - MP) * D, lane);
        }
    }
    SEAM(0);
    if (IN(1)) { PHASE_VARS
        { pg8::GridSched S; S.init(U, WinT, MP, NIN, D, D, G, c); pg8::EpiBf16 E{Z, NIN}; pg8::gemm_phase(lds, S, E, D, D, D, tid); }
        { pg8::GridSched S; S.init(MN, WkvT, NMEM, 2 * D, D, D, G, (c + G - 172) % G); pg8::EpiKV E{out + O_PMK, out + O_PMV, KB, VB}; pg8::gemm_phase(lds, S, E, D, D, D, tid); }
        if (c >= 196) {
            __syncthreads();
            LAS float* scr = (LAS float*)(lds + wid * 16896);
            constexpr int I_SQ = 32 * 32, I_PB = 16 * 32;
            for (int it = (c - 196) * 8 + wid; it < 4 * I_SQ + I_PB; it += (G - 196) * 8) {
                int r = it;
                if (r < I_SQ) { transpose_item(p.in[20], D, D, WpaT, scr, r, lane); continue; } r -= I_SQ;
                if (r < I_SQ) { transpose_item(p.in[22], D, D, WoT, scr, r, lane); continue; } r -= I_SQ;
                if (r < I_SQ) { transpose_item(p.in[26], D, D, WqT, scr, r, lane); continue; } r -= I_SQ;
                if (r < I_SQ) { transpose_item(p.in[29], D, D, WxoT, scr, r, lane); continue; } r -= I_SQ;
                transpose_item(p.in[21], DC, D, WpbT, scr, r, lane);
            }
            {
                const float* wq = p.in[26];
                for (int i = (c - 196) * 8 + wid; i < D * D / 512; i += (G - 196) * 8) { const float gq_ = p.in[23][i >> 2]; const f32x4 a = gq_ * __builtin_nontemporal_load((const f32x4*)(wq + (size_t)i * 512 + lane * 8)), b = gq_ * __builtin_nontemporal_load((const f32x4*)(wq + (size_t)i * 512 + lane * 8 + 4));
                    u32x4 w; w.x = pk2h(a[0], a[1]); w.y = pk2h(a[2], a[3]); w.z = pk2h(b[0], b[1]); w.w = pk2h(b[2], b[3]); *(u32x4*)(WqN + (size_t)i * 512 + lane * 8) = w; }
            }
        }
    }
    SEAM(1);
    if (IN(2)) { PHASE_VARS
        {
            const int h = c & 15;
            LAS unsigned char* WR = lds; LAS unsigned char* WI = lds + 34816; LAS unsigned char* XA = lds + 69632;
            LAS float* Ab = (LAS float*)(lds + 87040); LAS float* Bb = (LAS float*)(lds + 87040 + 32768);
            LAS float* SEGP = (LAS float*)(lds + 69632); LAS float* SEGS = (LAS float*)(lds + 69632 + 2048);
            for (int q = tid; q < 2048; q += 512) { const int j = q >> 4, ck = q & 15;
                *(LAS u32x4*)(WR + j * 272 + ck * 16) = *(const u32x4*)(WrT + h * 16384 + j * 128 + ck * 8);
                *(LAS u32x4*)(WI + j * 272 + ck * 16) = *(const u32x4*)(WiT + h * 16384 + j * 128 + ck * 8); }
            const int i2 = tid & 63, tg = tid >> 6, chc = h * 128 + 2 * i2;
            float cw[4][2];
#pragma unroll
            for (int k = 0; k < 4; ++k) { cw[k][0] = p.in[12][k * D + chc]; cw[k][1] = p.in[12][k * D + chc + 1]; }
            const float cb0 = p.in[13][chc], cb1 = p.in[13][chc + 1];
            const int mb = wid & 1, nb = wid >> 1, l31 = lane & 31, hh = lane >> 5, jg = 32 * nb + l31, chg = h * 128 + jg;
            const float br = p.in[15][chg], bi = p.in[17][chg];
            const float sp8 = -8.0f * log1pf(__expf(-p.in[18][chg]));
            const int seg = tid >> 7, sch = tid & 127, schg = h * 128 + sch;
            unsigned zr[11];
#define ZR_ISSUE(ccn) do { _Pragma("unroll") for (int k = 0; k < 11; ++k) { const int grow = (ccn) * 64 + tg * 8 - 3 + k; zr[k] = grow >= 0 ? *(const unsigned*)(Z + (size_t)grow * NIN + chc) : 0u; } } while (0)
            if ((c >> 4) < 128) ZR_ISSUE(c >> 4);
            float carry_run = 0.f;
            LAS float* CARR = (LAS float*)(lds + 69632 + 4096);
            for (int cc = c >> 4; cc < NCHUNK; cc += 16) {
                const int r0 = cc * 64; const bool smp = cc >= 128;
                __syncthreads();
                {
                    float ra[11], rb[11]; const int t0 = tg * 8;
                    if (!smp) {
#pragma unroll
                        for (int k = 0; k < 11; ++k) { ra[k] = bf_lo(zr[k]); rb[k] = bf_hi(zr[k]); }
                        if (cc + 16 < 128) ZR_ISSUE(cc + 16);
                    } else {
#pragma unroll
                        for (int k = 0; k < 11; ++k) { const int pp = (t0 & 15) - 3 + k, b = (r0 - SEQ + t0) >> 4;
                            if (pp >= 0) { const unsigned u = *(const unsigned*)(Z + (size_t)(SEQ + b * 16 + pp) * NIN + chc); ra[k] = bf_lo(u); rb[k] = bf_hi(u); }
                            else { const float* sp = p.in[3] + (size_t)(b * 3 + 3 + pp) * D + chc; ra[k] = sp[0]; rb[k] = sp[1]; } }
                    }
#pragma unroll
                    for (int j = 0; j < 8; ++j) { const float o0 = cb0 + cw[0][0] * ra[j] + cw[1][0] * ra[j + 1] + cw[2][0] * ra[j + 2] + cw[3][0] * ra[j + 3];
                        const float o1 = cb1 + cw[0][1] * rb[j] + cw[1][1] * rb[j + 1] + cw[2][1] * rb[j + 2] + cw[3][1] * rb[j + 3];
                        *(LAS unsigned*)(XA + (t0 + j) * 272 + i2 * 4) = pk2h(o0, o1); }
                }
                __syncthreads();
                {
                    f32x16 accR, accI;
#pragma unroll
                    for (int e = 0; e < 16; ++e) { accR[e] = 0.f; accI[e] = 0.f; }
#pragma unroll
                    for (int kk = 0; kk < 8; ++kk) {
                        const bf16x8 a = *(const LAS bf16x8*)(XA + (32 * mb + l31) * 272 + (16 * kk + 8 * hh) * 2);
                        const bf16x8 b0 = *(const LAS bf16x8*)(WR + (32 * nb + l31) * 272 + (16 * kk + 8 * hh) * 2);
                        const bf16x8 b1 = *(const LAS bf16x8*)(WI + (32 * nb + l31) * 272 + (16 * kk + 8 * hh) * 2);
                        accR = __builtin_amdgcn_mfma_f32_32x32x16_bf16(a, b0, accR, 0, 0, 0);
                        accI = __builtin_amdgcn_mfma_f32_32x32x16_bf16(a, b1, accI, 0, 0, 0);
                    }
#pragma unroll
                    for (int e = 0; e < 16; ++e) { const int t = 32 * mb + (e & 3) + 8 * (e >> 2) + 4 * hh;
                        const float rr = sigmoidf_(accR[e] + br), ii = sigmoidf_(accI[e] + bi);
                        const float la = sp8 * rr; const float a = __expf(la); float mult = __builtin_amdgcn_sqrtf(1.0f - a * a);
                        if (r0 + t == 0) mult = 1.0f;
                        const float xv = bf1(*(const LAS bf16_t*)(XA + t * 272 + jg * 2));
                        Ab[t * 128 + jg] = a; Bb[t * 128 + jg] = mult * ii * xv; }
                }
                const bf16_t* gap_ = Z + (size_t)(r0 + (tid >> 3)) * NIN + Z_GA + h * 128 + (tid & 7) * 16;
                const u32x4 gq0 = *(const u32x4*)gap_, gq1 = *(const u32x4*)(gap_ + 8);
                __syncthreads();
                if (!smp) {
                    float Pp = 1.f, Ss = 0.f;
#pragma unroll
                    for (int t = 0; t < 16; ++t) { const float a = Ab[(seg * 16 + t) * 128 + sch], b = Bb[(seg * 16 + t) * 128 + sch]; Ss = a * Ss + b; Pp *= a; }
                    SEGP[seg * 128 + sch] = Pp; SEGS[seg * 128 + sch] = Ss;
                    __syncthreads();
                    float cp = 1.f, hv = 0.f;
                    for (int s2 = 0; s2 < seg; ++s2) { const float pp = SEGP[s2 * 128 + sch], ss = SEGS[s2 * 128 + sch]; hv = pp * hv + ss; cp *= pp; }
#pragma unroll
                    for (int t = 0; t < 16; ++t) { const int o = (seg * 16 + t) * 128 + sch; const float a = Ab[o], b = Bb[o]; hv = a * hv + b; cp *= a; Ab[o] = hv; Bb[o] = cp; }
                    if (seg == 3) __hip_atomic_store(PS2 + (size_t)cc * D + schg, ((unsigned long long)__float_as_uint(hv) << 32) | __float_as_uint(cp), __ATOMIC_RELAXED, __HIP_MEMORY_SCOPE_AGENT);
                } else {
                    const int b = (cc - 128) * 4 + seg; float hv = p.in[4][b * D + schg];
#pragma unroll
                    for (int t = 0; t < 16; ++t) { const int o = (seg * 16 + t) * 128 + sch; const float a = Ab[o], bb = Bb[o]; hv = a * hv + bb; Ab[o] = hv; Bb[o] = 0.f; }
                    out[O_SRH + b * D + schg] = hv;
                    __syncthreads();
                }
                asm volatile("s_waitcnt vmcnt(0)" ::: "memory");
                __syncthreads();
                if (!smp) {
                    if (tid == 0) __hip_atomic_store(FLG + cc * 16 + h, 1u, __ATOMIC_RELAXED, __HIP_MEMORY_SCOPE_AGENT);
                    const int lo = cc < 16 ? 0 : cc - 16;
                    if (wid == 1) {
                        const int j = lo + lane;
                        if (j < cc) { unsigned spn = 0u; while (__hip_atomic_load(FLG + j * 16 + h, __ATOMIC_RELAXED, __HIP_MEMORY_SCOPE_AGENT) == 0u) { __builtin_amdgcn_s_sleep(1); if (++spn > (1u << 22)) break; } }
                    }
                    __syncthreads();
                    if (tid < 128) {
                        float pj[16], sj[16]; const int jmax = cc > 0 ? cc - 1 : 0;
#pragma unroll
                        for (int i = 0; i < 16; ++i) { const int jj = (lo + i) < jmax ? (lo + i) : jmax; const unsigned long long v = __hip_atomic_load(PS2 + (size_t)jj * D + h * 128 + tid, __ATOMIC_RELAXED, __HIP_MEMORY_SCOPE_AGENT); pj[i] = __uint_as_float((unsigned)v); sj[i] = __uint_as_float((unsigned)(v >> 32)); }
                        float cr = carry_run;
#pragma unroll
                        for (int i = 0; i < 16; ++i) cr = ((lo + i) < cc) ? pj[i] * cr + sj[i] : cr;
                        carry_run = cr; CARR[tid] = cr;
                        if (cc == 127) out[O_PRH + h * 128 + tid] = Ab[63 * 128 + tid] + Bb[63 * 128 + tid] * cr;
                    }
                } else { if (tid < 128) CARR[tid] = 0.f; }
                __syncthreads();
                {
                    const int row = tid >> 3, c16 = (tid & 7) * 16; const size_t o = (size_t)(r0 + row) * D + h * 128 + c16;
                    const LAS float* ha = Ab + row * 128 + c16; const LAS float* ca = Bb + row * 128 + c16; const LAS float* cr = CARR + c16;
                    float ov[16];
#pragma unroll
                    for (int q4 = 0; q4 < 4; ++q4) { const f32x4 hv4 = *(const LAS f32x4*)(ha + 4 * q4), cp4 = *(const LAS f32x4*)(ca + 4 * q4), cr4 = *(const LAS f32x4*)(cr + 4 * q4);
                        const unsigned g01 = q4 < 2 ? (q4 == 0 ? gq0.x : gq0.z) : (q4 == 2 ? gq1.x : gq1.z), g23 = q4 < 2 ? (q4 == 0 ? gq0.y : gq0.w) : (q4 == 2 ? gq1.y : gq1.w);
                        ov[4 * q4 + 0] = (hv4[0] + cp4[0] * cr4[0]) * gelu_tanh(bf_lo(g01)); ov[4 * q4 + 1] = (hv4[1] + cp4[1] * cr4[1]) * gelu_tanh(bf_hi(g01));
                        ov[4 * q4 + 2] = (hv4[2] + cp4[2] * cr4[2]) * gelu_tanh(bf_lo(g23)); ov[4 * q4 + 3] = (hv4[3] + cp4[3] * cr4[3]) * gelu_tanh(bf_hi(g23)); }
                    const u32x4 w0 = (u32x4){pk2h(ov[0], ov[1]), pk2h(ov[2], ov[3]), pk2h(ov[4], ov[5]), pk2h(ov[6], ov[7])}, w1 = (u32x4){pk2h(ov[8], ov[9]), pk2h(ov[10], ov[11]), pk2h(ov[12], ov[13]), pk2h(ov[14], ov[15])};
                    *(u32x4*)(HA + o) = w0; *(u32x4*)(HA + o + 8) = w1;
                }
            }
#undef ZR_ISSUE
        }
        if (c >= 32 && c < 64) {
            __syncthreads();
            pg8::MTSched S{c - 32, (const char*)KB, (const char*)WqN}; pg8::EpiBf16 E{MT, 8192}; pg8::gemm_phase(lds, S, E, 512, D, D, tid);
        }
        for (int w = c * 512 + tid; w < (MR / 16) * 256; w += G * 512) {
            const int rg = w >> 8, ch = (w & 255) * 4, r0 = rg * 16; const bool smp = r0 >= SEQ; const int b = (r0 - SEQ) >> 4;
            const f32x4 w0 = *(const f32x4*)(p.in[19] + ch), w1 = *(const f32x4*)(p.in[19] + DC + ch), w2 = *(const f32x4*)(p.in[19] + 2 * DC + ch);
            f32x4 m2, m1;
            if (smp) { m2 = *(const f32x4*)(p.in[5] + (size_t)b * 2 * DC + ch); m1 = *(const f32x4*)(p.in[5] + (size_t)b * 2 * DC + DC + ch); }
            else if (r0 == 0) { m2 = (f32x4){0.f, 0.f, 0.f, 0.f}; m1 = m2; }
            else { const bf16_t* z2 = Z + (size_t)(r0 - 2) * NIN + ch; const bf16_t* z1 = z2 + NIN;
                const u32x2 g2 = *(const u32x2*)(z2 + Z_GC), h2 = *(const u32x2*)(z2 + Z_HB), g1 = *(const u32x2*)(z1 + Z_GC), h1 = *(const u32x2*)(z1 + Z_HB);
                m2 = (f32x4){bf_lo(g2.x) * bf_lo(h2.x), bf_hi(g2.x) * bf_hi(h2.x), bf_lo(g2.y) * bf_lo(h2.y), bf_hi(g2.y) * bf_hi(h2.y)};
                m1 = (f32x4){bf_lo(g1.x) * bf_lo(h1.x), bf_hi(g1.x) * bf_hi(h1.x), bf_lo(g1.y) * bf_lo(h1.y), bf_hi(g1.y) * bf_hi(h1.y)}; }
#pragma unroll 8
            for (int t = 0; t < 16; ++t) { const bf16_t* z = Z + (size_t)(r0 + t) * NIN + ch;
                const u32x2 gc = *(const u32x2*)(z + Z_GC), hb = *(const u32x2*)(z + Z_HB), gb = *(const u32x2*)(z + Z_GB);
                const f32x4 cv = (f32x4){bf_lo(gc.x) * bf_lo(hb.x), bf_hi(gc.x) * bf_hi(hb.x), bf_lo(gc.y) * bf_lo(hb.y), bf_hi(gc.y) * bf_hi(hb.y)};
                const f32x4 gbf = (f32x4){bf_lo(gb.x), bf_hi(gb.x), bf_lo(gb.y), bf_hi(gb.y)};
                const f32x4 o = gbf * (w0 * m2 + w1 * m1 + w2 * cv);
                u32x2 ow; ow.x = pk2h(o[0], o[1]); ow.y = pk2h(o[2], o[3]); *(u32x2*)(HBb + (size_t)(r0 + t) * DC + ch) = ow;
                m2 = m1; m1 = cv; }
            if (smp) { float* o = out + O_SCB + (size_t)b * 2 * DC + ch; *(f32x4*)o = m2; *(f32x4*)(o + DC) = m1; }
            else if (r0 == SEQ - 16) { float* o = out + O_PCB + ch; *(f32x4*)o = m2; *(f32x4*)(o + DC) = m1; }
        }
        for (int e = c * 512 + tid; e < 9 * 3 * D; e += G * 512) { const int ch = e % D, k = (e / D) % 3, s = e / (3 * D);
            if (s == 0) out[O_PCA + k * D + ch] = bf1(Z[(size_t)(SEQ - 3 + k) * NIN + ch]);
            else out[O_SCA + (size_t)((s - 1) * 3 + k) * D + ch] = bf1(Z[(size_t)(SEQ + (s - 1) * 16 + 13 + k) * NIN + ch]); }
    }
    SEAM(2);
    if (IN(4)) { PHASE_VARS
        {
            const int r0 = SEQ + 32 * ((c >> 3) & 3), c0 = 32 * (8 * (c & 7) + (c >> 5));
            LAS float* red = (LAS float*)lds;
            const f32x16 accA = thin_mac_lds<1024>(lds, HA + (size_t)r0 * D, WpaT + (size_t)c0 * D, D, tid, wid, lane);
            const f32x16 accB = thin_mac_lds<1024>(lds, HBb + (size_t)r0 * DC, WpbT + (size_t)c0 * DC, DC, tid, wid, lane);
            __syncthreads();
            thin_put(red, accA, wid, lane);
            thin_put(red + 8192, accB, wid, lane);
            __syncthreads();
            float a0, a1, b0, b1; thin_get(red, tid, a0, a1); thin_get(red + 8192, tid, b0, b1);
            const int row = r0 + (tid >> 4), col = c0 + (tid & 15) * 2;
            const unsigned ga = *(const unsigned*)(Z + (size_t)row * NIN + Z_GATEA + col), gb = *(const unsigned*)(Z + (size_t)row * NIN + Z_GATEB + col);
            *(unsigned*)(MIX + (size_t)row * D + col) = pk2h(sigmoidf_(bf_lo(ga)) * a0 + sigmoidf_(bf_lo(gb)) * b0, sigmoidf_(bf_hi(ga)) * a1 + sigmoidf_(bf_hi(gb)) * b1);
            __syncthreads();
        }
#pragma unroll 1
        for (int pass_ = 0; pass_ < 2; ++pass_) {
            const bf16_t* A_ = pass_ ? HBb : HA; const bf16_t* B_ = pass_ ? WpbT : WpaT; const int K_ = pass_ ? DC : D;
            pg8::GridSched S; S.init(A_, B_, SEQ, D, K_, K_, G, c); pg8::EpiMix E{Z, MIX, pass_}; pg8::gemm_phase(lds, S, E, K_, K_, K_, tid);
        }
    }
    SEAM(4);
    if (IN(5)) { PHASE_VARS thin_gemm_bf16<1024>(lds, MIX, WoT, D, T, c, tid, wid, lane); pg8::GridSched S; S.init(MIX, WoT, SEQ, D, D, D, G, c); pg8::EpiBf16 E{T, D}; pg8::gemm_phase(lds, S, E, D, D, D, tid); }
    SEAM(5);
    if (IN(6)) { PHASE_VARS
        for (int m = gw; m < MR; m += NGW) { const float* xr = m < SEQ ? p.in[0] + (size_t)m * D : p.in[1] + (size_t)(m - SEQ) * D;
            if (m < SEQ) row_pass<true, 1, 1>(T + (size_t)m * D, xr, X1B + (size_t)m * D, p.in[10], p.in[23], nullptr, lane, RS1 + m);
            else row_pass<true, 1, 0>(T + (size_t)m * D, xr, X1B + (size_t)m * D, p.in[10], p.in[23], U2 + (size_t)m * D, lane); }
    }
    SEAM(6);
    if (IN(7)) { PHASE_VARS thin_gemm_bf16<1024>(lds, U2, WqT, D, Qb, c, tid, wid, lane); }
    SEAM(7);
    if (IN(8)) { PHASE_VARS
        if (c < 128) {
            pg8::AttnSSched S{G, c, (const char*)X1B, (const char*)MT}; pg8::EpiSoftmax E{Pb, 1024, 0.044194173824159216f * 1.4426950408889634f, RS1};
            pg8::gemm_phase(lds, S, E, D, D, 8192, tid);
        } else {
            if (c >= 192) {
                LAS float* scr = (LAS float*)(lds + wid * 16896);
                for (int it = (c - 192) * 8 + wid; it < 32 * 176; it += (G - 192) * 8) transpose_item(p.in[32], D, NUP, WupT, scr, it, lane);
            } else if (c >= 160) {
                pg8::NTSched S{c - 160, (const char*)WxoT, (const char*)VB}; pg8::EpiBf16 E{NT, 1024}; pg8::gemm_phase(lds, S, E, 512, D, D, tid);
            }
            for (int it = c - 128; it < 32; it += (G - 128)) {
                const int b = it >> 2, h = it & 3, R0 = SEQ + b * 16, fr = lane & 15, fq = lane >> 4;
                LAS float* Sc = (LAS float*)lds; LAS float* Pt = (LAS float*)(lds + 16384);
                __syncthreads();
                {
                    bf16x8 qf[16];
#pragma unroll
                    for (int s = 0; s < 16; ++s) qf[s] = *(const bf16x8*)(Qb + (size_t)(R0 + fr) * D + h * 512 + s * 32 + fq * 8);
#pragma unroll
                    for (int kb2 = 0; kb2 < 2; ++kb2) { const int key = (wid * 2 + kb2) * 16 + fr; f32x4 acc = (f32x4){0.f, 0.f, 0.f, 0.f};
                        const float* kp = p.in[7] + ((size_t)(b * 256 + key) * 4 + h) * 512 + fq * 8;
#pragma unroll
                        for (int s = 0; s < 16; ++s) { const f32x4 k0 = *(const f32x4*)(kp + s * 32), k1 = *(const f32x4*)(kp + s * 32 + 4);
                            u32x4 w; w.x = pk2h(k0[0], k0[1]); w.y = pk2h(k0[2], k0[3]); w.z = pk2h(k1[0], k1[1]); w.w = pk2h(k1[2], k1[3]);
                            acc = __builtin_amdgcn_mfma_f32_16x16x32_bf16(qf[s], __builtin_bit_cast(bf16x8, w), acc, 0, 0, 0); }
#pragma unroll
                        for (int e = 0; e < 4; ++e) Sc[(4 * fq + e) * 256 + key] = acc[e] * 0.044194173824159216f; }
                }
                __syncthreads();
#pragma unroll
                for (int qq = 0; qq < 2; ++qq) { const int q = wid * 2 + qq; float v[4]; float mx = -3.0e38f;
#pragma unroll
                    for (int i = 0; i < 4; ++i) { v[i] = Sc[q * 256 + lane + 64 * i]; mx = fmaxf(mx, v[i]); }
                    mx = wave_max(mx); float s = 0.f;
#pragma unroll
                    for (int i = 0; i < 4; ++i) { v[i] = __expf(v[i] - mx); s += v[i]; }
                    s = 1.0f / wave_sum(s);
#pragma unroll
                    for (int i = 0; i < 4; ++i) Pt[(lane + 64 * i) * 16 + q] = v[i] * s; }
                __syncthreads();
                {
                    float acc[16];
#pragma unroll
                    for (int q = 0; q < 16; ++q) acc[q] = 0.f;
                    const float* vp = p.in[8] + ((size_t)(b * 256) * 4 + h) * 512 + tid;
#pragma unroll 4
                    for (int m = 0; m < 256; ++m) { const float v = vp[(size_t)m * 2048];
#pragma unroll
                        for (int q4 = 0; q4 < 4; ++q4) { const f32x4 pr = *(const LAS f32x4*)(Pt + m * 16 + q4 * 4);
                            acc[q4 * 4 + 0] += pr[0] * v; acc[q4 * 4 + 1] += pr[1] * v; acc[q4 * 4 + 2] += pr[2] * v; acc[q4 * 4 + 3] += pr[3] * v; } }
#pragma unroll
                    for (int q = 0; q < 16; ++q) Ob[(size_t)(R0 + q) * D + h * 512 + tid] = (bf16_t)f2bf(acc[q]);
                }
            }
        }
    }
    SEAM(8);
    if (IN(10)) { PHASE_VARS thin_gemm_bf16<1024>(lds, Ob, WxoT, D, T2, c, tid, wid, lane); pg8::GridSched S; S.init(Pb, NT, SEQ, D, 1024, 1024, G, c); pg8::EpiBf16 E{T2, D}; pg8::gemm_phase(lds, S, E, 1024, 1024, 1024, tid); }
    SEAM(10);
    if (IN(11)) { PHASE_VARS
        LAS float* scr = (LAS float*)(lds + wid * 16896);
        constexpr int I_UP = 32 * 176, I_DN = 88 * 32;
        (void)scr; (void)I_UP;
        (void)I_DN;
        for (int m = gw; m < MR; m += NGW)
            row_pass<true, 3>(T2 + (size_t)m * D, X1B + (size_t)m * D, (bf16_t*)(out + (size_t)m * D) + D, p.in[24], p.in[30], U3 + (size_t)m * D, lane);
    }
    SEAM(11);
    if (IN(12)) { PHASE_VARS pg8::GridSched S; S.init(U3, WupT, MP, NUP, D, D, G, c); pg8::EpiBf16 E{UP, NUP}; pg8::gemm_phase(lds, S, E, D, D, D, tid);
        if (c >= 172) {
            __syncthreads();
            LAS float* scr = (LAS float*)(lds + wid * 16896);
            for (int it = (c - 172) * 8 + wid; it < 88 * 32; it += (G - 172) * 8) transpose_item(p.in[35], DFF, D, WdnT, scr, it, lane);
        } }
    SEAM(12);
    if (IN(13)) { PHASE_VARS
        constexpr int NCG = DFF / 8;
        const float* cwp = p.in[33]; const float* cbp = p.in[34];
        for (int w = c * 512 + tid; w < (MR / 16) * NCG; w += G * 512) {
            const int rg = w / NCG, cg = w - rg * NCG, r0 = rg * 16, ch = cg * 8; const bool smp = r0 >= SEQ; const int b = (r0 - SEQ) >> 4;
            float wg[3][8], wv[3][8], bg[8], bv[8], g2[8], g1[8], v2[8], v1[8];
#pragma unroll
            for (int k = 0; k < 3; ++k) { const f32x4 a0 = *(const f32x4*)(cwp + k * NUP + ch), a1 = *(const f32x4*)(cwp + k * NUP + ch + 4), c0 = *(const f32x4*)(cwp + k * NUP + DFF + ch), c1 = *(const f32x4*)(cwp + k * NUP + DFF + ch + 4);
#pragma unroll
                for (int e = 0; e < 4; ++e) { wg[k][e] = a0[e]; wg[k][4 + e] = a1[e]; wv[k][e] = c0[e]; wv[k][4 + e] = c1[e]; } }
            { const f32x4 a0 = *(const f32x4*)(cbp + ch), a1 = *(const f32x4*)(cbp + ch + 4), c0 = *(const f32x4*)(cbp + DFF + ch), c1 = *(const f32x4*)(cbp + DFF + ch + 4);
#pragma unroll
                for (int e = 0; e < 4; ++e) { bg[e] = a0[e]; bg[4 + e] = a1[e]; bv[e] = c0[e]; bv[4 + e] = c1[e]; } }
            if (smp) { const float* s0 = p.in[6] + (size_t)b * 2 * NUP + ch;
#pragma unroll
                for (int e = 0; e < 8; ++e) { g2[e] = s0[e]; v2[e] = s0[DFF + e]; g1[e] = s0[NUP + e]; v1[e] = s0[NUP + DFF + e]; } }
            else if (r0 == 0) {
#pragma unroll
                for (int e = 0; e < 8; ++e) { g2[e] = 0.f; g1[e] = 0.f; v2[e] = 0.f; v1[e] = 0.f; } }
            else { const bf16_t* u2 = UP + (size_t)(r0 - 2) * NUP + ch; const u32x4 a2 = *(const u32x4*)u2, c2 = *(const u32x4*)(u2 + DFF), a1 = *(const u32x4*)(u2 + NUP), c1 = *(const u32x4*)(u2 + NUP + DFF);
#pragma unroll
                for (int e = 0; e < 4; ++e) { g2[2 * e] = bf_lo(a2[e]); g2[2 * e + 1] = bf_hi(a2[e]); v2[2 * e] = bf_lo(c2[e]); v2[2 * e + 1] = bf_hi(c2[e]);
                    g1[2 * e] = bf_lo(a1[e]); g1[2 * e + 1] = bf_hi(a1[e]); v1[2 * e] = bf_lo(c1[e]); v1[2 * e + 1] = bf_hi(c1[e]); } }
#pragma unroll 2
            for (int t = 0; t < 16; ++t) { const bf16_t* u = UP + (size_t)(r0 + t) * NUP + ch; const u32x4 ua = *(const u32x4*)u, uc = *(const u32x4*)(u + DFF);
                float ga[8], va[8], o[8];
#pragma unroll
                for (int e = 0; e < 4; ++e) { ga[2 * e] = bf_lo(ua[e]); ga[2 * e + 1] = bf_hi(ua[e]); va[2 * e] = bf_lo(uc[e]); va[2 * e + 1] = bf_hi(uc[e]); }
#pragma unroll
                for (int e = 0; e < 8; ++e) { const float yg = bg[e] + wg[0][e] * g2[e] + wg[1][e] * g1[e] + wg[2][e] * ga[e], yv = bv[e] + wv[0][e] * v2[e] + wv[1][e] * v1[e] + wv[2][e] * va[e];
                    o[e] = gelu_tanh(yg) * yv; g2[e] = g1[e]; g1[e] = ga[e]; v2[e] = v1[e]; v1[e] = va[e]; }
                u32x4 ow; ow.x = pk2h(o[0], o[1]); ow.y = pk2h(o[2], o[3]); ow.z = pk2h(o[4], o[5]); ow.w = pk2h(o[6], o[7]);
                *(u32x4*)(Gb + (size_t)(r0 + t) * DFF + ch) = ow; }
            if (smp || r0 == SEQ - 16) { float* o = (smp ? out + O_SCF + (size_t)b * 2 * NUP : out + O_PCF) + ch;
#pragma unroll
                for (int e = 0; e < 8; ++e) { o[e] = g2[e]; o[DFF + e] = v2[e]; o[NUP + e] = g1[e]; o[NUP + DFF + e] = v1[e]; } }
        }
    }
    SEAM(13);
    if (IN(14)) { PHASE_VARS thin_gemm_bf16<512>(lds, Gb, WdnT, DFF, T, c, tid, wid, lane); pg8::GridSched S; S.init(Gb, WdnT, SEQ, D, DFF, DFF, G, c); pg8::EpiBf16 E{T, D}; pg8::gemm_phase(lds, S, E, DFF, DFF, DFF, tid); }
    SEAM(14);
    if (IN(15)) { PHASE_VARS
        for (int m = gw; m < MR; m += 2 * NGW) {
            if (m + NGW < MR) { const bf16_t* const tr[2] = {T + (size_t)m * D, T + (size_t)(m + NGW) * D}; float* const sl[2] = {out + (size_t)m * D, out + (size_t)(m + NGW) * D}; final_row_pass<2>(tr, sl, p.in[31], lane); }
            else { const bf16_t* const tr[1] = {T + (size_t)m * D}; float* const sl[1] = {out + (size_t)m * D}; final_row_pass<1>(tr, sl, p.in[31], lane); }
        }
    }
    if (p.ph_lo < 0) grid.sync();
#undef IN
#undef SEAM
#undef out
#undef WSP
#undef WinT
#undef WkvT
#undef WpaT
#undef WpbT
#undef WoT
#undef WqT
#undef WxoT
#undef WrT
#undef WiT
#undef WupT
#undef WdnT
#undef KB
#undef VB
#undef NT
#undef WqN
#undef MT
#undef RS1
#undef MN
#undef PSP
#undef PSS
#undef FLG
#undef PS2
#undef Z
#undef UP
#undef X1B
#undef T
#undef U
#undef HLOC
#undef MIX
#undef Qb
#undef CP
#undef U2
#undef Ob
#undef HA
#undef Pb
#undef HBb
#undef U3
#undef T2
#undef Gb
#undef PHASE_VARS
}
constexpr int NPH = 16;

extern "C" void kernel_launch(void* const* d_in, const int* in_sizes, int n_in, void* d_out, int out_size, void* d_ws, size_t ws_size, hipStream_t stream) {
    static int grid = 0;
    if (grid == 0) {
        if (n_in != 36 || out_size != 18382848 || ws_size < WS_END + 16777216 + 65536) { fprintf(stderr, "kernel_launch: unexpected shapes: n_in %d out %d ws %zu (need %zu)\n", n_in, out_size, ws_size, (size_t)WS_END); grid = -1; return; }
        int dev = 0, cus = 0, per_cu = 0;
        hipGetDevice(&dev); hipDeviceGetAttribute(&cus, hipDeviceAttributeMultiprocessorCount, dev);
        if (hipFuncSetAttribute((const void*)mega, hipFuncAttributeMaxDynamicSharedMemorySize, LDS_BYTES) != hipSuccess) { fprintf(stderr, "kernel_launch: hipFuncSetAttribute failed\n"); grid = -1; return; }
        hipOccupancyMaxActiveBlocksPerMultiprocessor(&per_cu, (const void*)mega, 512, LDS_BYTES);
        if (per_cu < 1 || cus * per_cu < 256) { fprintf(stderr, "kernel_launch: occupancy %d x %d CUs < 256 workgroups\n", per_cu, cus); grid = -1; return; }
        grid = 256;
    }
    if (grid < 0) return;
    hipMemsetAsync((char*)d_ws + WS_BAR, 0, 32768, stream);
    Params p{};
    for (int i = 0; i < 36; ++i) p.in[i] = (const float*)d_in[i];
    p.out = (float*)d_out; p.ws = (unsigned char*)d_ws;
#if PROBE_PH >= 0
    { const int cuts[4] = {0, PROBE_PH + 1, PROBE_PH, NPH}; const int ends[3] = {PROBE_PH + 1, PROBE_PH + 1, NPH};
      for (int k = 0; k < 3; ++k) { p.ph_lo = (k == 0) ? 0 : (k == 1 ? PROBE_PH : PROBE_PH + 1); p.ph_hi = ends[k]; (void)cuts; void* args[] = {&p};
        if (k > 0) (void)hipMemsetAsync((char*)d_ws + WS_BAR, 0, 32768, stream);
        hipError_t e = hipLaunchCooperativeKernel((const void*)mega, dim3(grid), dim3(512), args, LDS_BYTES, stream);
        if (e != hipSuccess) { fprintf(stderr, "launch %d failed: %s\n", k, hipGetErrorString(e)); break; } } }
#elif N_LAUNCH_MODE == 1
    p.ph_lo = 0; p.ph_hi = NPH;
    { void* args[] = {&p}; hipError_t e = hipLaunchCooperativeKernel((const void*)mega, dim3(grid), dim3(512), args, LDS_BYTES, stream);
      if (e != hipSuccess) fprintf(stderr, "cooperative launch failed: %s\n", hipGetErrorString(e)); }
#else
    for (int k = 0; k < NPH; ++k) { p.ph_lo = k; p.ph_hi = k + 1; void* args[] = {&p};
        hipError_t e = hipLaunchCooperativeKernel((const void*)mega, dim3(grid), dim3(512), args, LDS_BYTES, stream);
        if (e != hipSuccess) { fprintf(stderr, "launch %d failed: %s\n", k, hipGetErrorString(e)); break; } }
#endif
}
```
